# Optimizing an MI355X kernel written in HIP

```python
import math
import jax, jax.numpy as jnp
from jax import lax
import numpy as np

D_MODEL = 1024
BATCH = 8
SEQ = 4096
DEPTH = 2

N_HEADS_A = 8
HEAD_DIM_A = 128
CONV_A = 4
CHUNK = 64
N_HEADS_B = 16
N_KV_B = 4
HEAD_DIM_B = 64
WINDOW = 128
D_FF = 2816
FFN_CONV = 3
PLE_DIM = 256
EPS = 1e-6
N_A_LAYERS = (DEPTH + 1) // 2
N_B_LAYERS = DEPTH // 2

kernel_name = "hybrid_deltanet_swa_convffn_ple"


def rmsnorm(x, w):
    x32 = x.astype(jnp.float32)
    y = x32 * lax.rsqrt(jnp.mean(x32 * x32, axis=-1, keepdims=True) + EPS)
    return (y * w.astype(jnp.float32)).astype(x.dtype)


def l2norm(x):
    x32 = x.astype(jnp.float32)
    return x32 * lax.rsqrt(jnp.sum(x32 * x32, axis=-1, keepdims=True) + EPS)


def causal_dwconv(x, w):
    k_w = w.shape[0]
    t = x.shape[1]
    xp = jnp.pad(x, ((0, 0), (k_w - 1, 0), (0, 0)))
    y = w[0] * xp[:, 0:t]
    for i in range(1, k_w):
        y = y + w[i] * xp[:, i:i + t]
    return y


def gated_delta_rule(q, k, v, g, beta):
    b_, t_, h_, dk = q.shape
    dv = v.shape[-1]
    n_ch = t_ // CHUNK
    f32 = jnp.float32

    def chunks(a):
        return a.astype(f32).reshape(b_, n_ch, CHUNK, h_, a.shape[-1]).transpose(1, 0, 3, 2, 4)

    qc = chunks(q) * (dk ** -0.5)
    kc = chunks(k)
    vc = chunks(v)
    gcs = jnp.cumsum(g.astype(f32).reshape(b_, n_ch, CHUNK, h_).transpose(1, 0, 3, 2), axis=-1)
    bc = beta.astype(f32).reshape(b_, n_ch, CHUNK, h_).transpose(1, 0, 3, 2)

    idx = jnp.arange(CHUNK)
    incl = idx[:, None] >= idx[None, :]
    strict = idx[:, None] > idx[None, :]
    diff = gcs[..., :, None] - gcs[..., None, :]
    decay = jnp.exp(jnp.where(incl, diff, -jnp.inf))

    kk = jnp.einsum('nbhik,nbhjk->nbhij', kc, kc)
    lmat = jnp.where(strict, bc[..., :, None] * kk * decay, 0.0)
    eye_l = jnp.eye(CHUNK, dtype=f32) + lmat
    rhs = jnp.concatenate([bc[..., None] * vc,
                           (bc * jnp.exp(gcs))[..., None] * kc], axis=-1)
    sol = lax.linalg.triangular_solve(eye_l, rhs, left_side=True, lower=True, unit_diagonal=True)
    u0 = sol[..., :dv]
    wk = sol[..., dv:]

    qk = jnp.einsum('nbhik,nbhjk->nbhij', qc, kc) * decay
    q_dec = qc * jnp.exp(gcs)[..., None]
    k_dec = kc * jnp.exp(gcs[..., -1:] - gcs)[..., None]
    g_last = jnp.exp(gcs[..., -1])

    def step(s, inp):
        qd, kd, qkc, u0c, wc, gl = inp
        u = u0c - jnp.einsum('bhck,bhkv->bhcv', wc, s)
        o = jnp.einsum('bhck,bhkv->bhcv', qd, s) + jnp.einsum('bhij,bhjv->bhiv', qkc, u)
        s = gl[..., None, None] * s + jnp.einsum('bhck,bhcv->bhkv', kd, u)
        return s, o

    s0 = jnp.zeros((b_, h_, dk, dv), f32)
    _, o = lax.scan(step, s0, (q_dec, k_dec, qk, u0, wk, g_last))
    return o.transpose(1, 0, 3, 2, 4).reshape(b_, t_, h_, dv)


def deltanet_mixer(x, w_in, conv_w, a_log, dt_bias, norm_w, w_out):
    b_, t_, _ = x.shape
    hk = N_HEADS_A * HEAD_DIM_A
    proj = x @ w_in
    qkv = jax.nn.silu(causal_dwconv(proj[..., :3 * hk], conv_w))
    z = proj[..., 3 * hk:4 * hk].reshape(b_, t_, N_HEADS_A, HEAD_DIM_A)
    b_logit = proj[..., 4 * hk:4 * hk + N_HEADS_A]
    a_in = proj[..., 4 * hk + N_HEADS_A:]
    q = l2norm(qkv[..., :hk].reshape(b_, t_, N_HEADS_A, HEAD_DIM_A))
    k = l2norm(qkv[..., hk:2 * hk].reshape(b_, t_, N_HEADS_A, HEAD_DIM_A))
    v = qkv[..., 2 * hk:].reshape(b_, t_, N_HEADS_A, HEAD_DIM_A)
    beta = jax.nn.sigmoid(b_logit.astype(jnp.float32))
    g = -jnp.exp(a_log.astype(jnp.float32)) * jax.nn.softplus(a_in.astype(jnp.float32) + dt_bias.astype(jnp.float32))
    o = gated_delta_rule(q, k, v, g, beta).astype(x.dtype)
    o = rmsnorm(o, norm_w) * jax.nn.silu(z)
    return o.reshape(b_, t_, hk) @ w_out


def alibi_slopes(n_heads):
    return 2.0 ** (-8.0 * jnp.arange(1, n_heads + 1, dtype=jnp.float32) / n_heads)


def swa_mixer(x, w_in, sinks, w_out):
    b_, t_, _ = x.shape
    n_blk = t_ // WINDOW
    grp = N_HEADS_B // N_KV_B
    qd = N_HEADS_B * HEAD_DIM_B
    kd = N_KV_B * HEAD_DIM_B
    proj = x @ w_in
    q = proj[..., :qd].reshape(b_, n_blk, WINDOW, N_KV_B, grp, HEAD_DIM_B)
    k = proj[..., qd:qd + kd].reshape(b_, n_blk, WINDOW, N_KV_B, HEAD_DIM_B)
    v = proj[..., qd + kd:].reshape(b_, n_blk, WINDOW, N_KV_B, HEAD_DIM_B)

    def with_prev(a):
        prev = jnp.pad(a[:, :-1], ((0, 0), (1, 0), (0, 0), (0, 0), (0, 0)))
        return jnp.concatenate([prev, a], axis=2)

    kb, vb = with_prev(k), with_prev(v)
    scores = jnp.einsum('bnqhgd,bnkhd->bhgnqk', q, kb).astype(jnp.float32) * (HEAD_DIM_B ** -0.5)
    qi = jnp.arange(WINDOW)[:, None]
    kj = jnp.arange(2 * WINDOW)[None, :]
    dist = qi + WINDOW - kj
    blk = jnp.arange(n_blk)[:, None, None]
    valid = (dist >= 0) & (dist < WINDOW) & (blk * WINDOW - WINDOW + kj >= 0)
    slopes = alibi_slopes(N_HEADS_B).reshape(N_KV_B, grp)
    logits = scores - slopes[None, :, :, None, None, None] * dist.astype(jnp.float32)
    logits = jnp.where(valid, logits, -jnp.inf)
    sink = sinks.astype(jnp.float32).reshape(1, N_KV_B, grp, 1, 1, 1)
    m = jnp.maximum(jnp.max(logits, axis=-1, keepdims=True), sink)
    e = jnp.exp(logits - m)
    probs = e / (jnp.sum(e, axis=-1, keepdims=True) + jnp.exp(sink - m))
    out = jnp.einsum('bhgnqk,bnkhd->bnqhgd', probs.astype(x.dtype), vb).reshape(b_, t_, qd)
    return out @ w_out


def conv_ffn(x, w_up, conv_w, w_down):
    u = causal_dwconv(x @ w_up, conv_w)
    gate, val = u[..., :D_FF], u[..., D_FF:]
    return (jax.nn.silu(gate) * val) @ w_down


def setup_inputs(seed: int = 0) -> dict:
    key = jax.random.key(seed)
    ks = jax.random.split(key, 24)
    f32 = jnp.float32
    hk = N_HEADS_A * HEAD_DIM_A

    def dense(k, shape, fan_in):
        return jax.random.normal(k, shape, f32) * (fan_in ** -0.5)

    def gain(k, shape):
        return 1.0 + 0.02 * jax.random.normal(k, shape, f32)

    x = jax.random.normal(ks[0], (BATCH, SEQ, D_MODEL), f32)
    p = jax.random.normal(ks[1], (DEPTH, BATCH, SEQ, PLE_DIM), f32)
    norm_mix = gain(ks[2], (DEPTH, D_MODEL))
    norm_ffn = gain(ks[3], (DEPTH, D_MODEL))
    norm_ple = gain(ks[4], (DEPTH, D_MODEL))
    norm_final = gain(ks[5], (D_MODEL,))

    a_w_in = dense(ks[6], (N_A_LAYERS, D_MODEL, 4 * hk + 2 * N_HEADS_A), D_MODEL)
    a_conv = jax.random.normal(ks[7], (N_A_LAYERS, CONV_A, 3 * hk), f32) * (CONV_A ** -0.5)
    a_log = jnp.log(jax.random.uniform(ks[8], (N_A_LAYERS, N_HEADS_A), f32, 1.0, 16.0))
    dt = jnp.exp(jax.random.uniform(ks[9], (N_A_LAYERS, N_HEADS_A), f32, math.log(1e-3), math.log(1e-1)))
    a_dt_bias = dt + jnp.log(-jnp.expm1(-dt))
    a_norm = gain(ks[10], (N_A_LAYERS, HEAD_DIM_A))
    a_w_out = dense(ks[11], (N_A_LAYERS, hk, D_MODEL), hk)

    qd = N_HEADS_B * HEAD_DIM_B
    kd = N_KV_B * HEAD_DIM_B
    b_w_in = dense(ks[12], (N_B_LAYERS, D_MODEL, qd + 2 * kd), D_MODEL)
    b_sinks = jax.random.normal(ks[13], (N_B_LAYERS, N_HEADS_B), f32)
    b_w_out = dense(ks[14], (N_B_LAYERS, qd, D_MODEL), qd)

    f_w_up = dense(ks[15], (DEPTH, D_MODEL, 2 * D_FF), D_MODEL)
    f_conv = jax.random.normal(ks[16], (DEPTH, FFN_CONV, 2 * D_FF), f32) * (FFN_CONV ** -0.5)
    f_w_down = dense(ks[17], (DEPTH, D_FF, D_MODEL), D_FF)

    ple_w_proj = dense(ks[18], (DEPTH, PLE_DIM, D_MODEL), PLE_DIM)
    ple_w_gate = dense(ks[19], (DEPTH, D_MODEL, D_MODEL), D_MODEL)

    return {"x": x, "p": p, "norm_mix": norm_mix, "norm_ffn": norm_ffn,
            "norm_ple": norm_ple, "norm_final": norm_final,
            "a_w_in": a_w_in, "a_conv": a_conv, "a_log": a_log, "a_dt_bias": a_dt_bias,
            "a_norm": a_norm, "a_w_out": a_w_out,
            "b_w_in": b_w_in, "b_sinks": b_sinks, "b_w_out": b_w_out,
            "f_w_up": f_w_up, "f_conv": f_conv, "f_w_down": f_w_down,
            "ple_w_proj": ple_w_proj, "ple_w_gate": ple_w_gate}


def reference(x, p, norm_mix, norm_ffn, norm_ple, norm_final,
              a_w_in, a_conv, a_log, a_dt_bias, a_norm, a_w_out,
              b_w_in, b_sinks, b_w_out,
              f_w_up, f_conv, f_w_down,
              ple_w_proj, ple_w_gate):
    h = x
    for i in range(DEPTH):
        hn = rmsnorm(h, norm_mix[i])
        j = i // 2
        if i % 2 == 0:
            mix = deltanet_mixer(hn, a_w_in[j], a_conv[j], a_log[j], a_dt_bias[j], a_norm[j], a_w_out[j])
        else:
            mix = swa_mixer(hn, b_w_in[j], b_sinks[j], b_w_out[j])
        h = h + mix
        h = h + conv_ffn(rmsnorm(h, norm_ffn[i]), f_w_up[i], f_conv[i], f_w_down[i])
        gate = jax.nn.sigmoid(rmsnorm(h, norm_ple[i]) @ ple_w_gate[i])
        h = h + gate * (p[i] @ ple_w_proj[i])
    return rmsnorm(h, norm_final)
```

```cpp
#include <hip/hip_runtime.h>
#include <hip/hip_cooperative_groups.h>
#include <cstdio>
namespace cg = cooperative_groups;
namespace pg8 {
#define PG8_LAS __attribute__((address_space(3)))
typedef unsigned short bf16_t;
typedef short bf16x8 __attribute__((ext_vector_type(8)));
typedef float f32x4 __attribute__((ext_vector_type(4)));
typedef unsigned u32x4 __attribute__((ext_vector_type(4)));
constexpr int BM = 256, BK = 64, HALF = 128, HTB = HALF * BK * 2  , STAGE_BYTES = 8 * HTB, NXCD = 8, WGM = 8;

__host__ __device__ __forceinline__ int lds_byte(int r, int c) { const int st = (r >> 4) * 2 + (c >> 5), rr = r & 15, cc = c & 31, ob = rr * 64 + cc * 2; return st * 1024 + (ob ^ (((ob >> 9) & 1) << 5)); }
__host__ __device__ __forceinline__ void stage_rc(int b, int& R, int& C) { const int st = b / 1024, sb = b % 1024, swz = sb ^ (((sb >> 9) & 1) << 5); R = (st >> 1) * 16 + swz / 64; C = (st & 1) * 32 + (swz % 64) / 2; }
__host__ __device__ __forceinline__ int perm32(int rho) { const int n = rho >> 4, i = rho & 15; return 8 * (i >> 2) + 4 * n + (i & 3); }

struct Unit { int pm, pn; };
struct Gemm { const bf16_t* A; const bf16_t* Bt; int M, N, K; };

struct StaticOrder {
    int nM, nN, nwg, G, c;
    __host__ __device__ void init(int M, int N, int G_, int c_) { nM = M / BM; nN = N / BM; nwg = nM * nN; G = G_; c = c_; }
    __host__ __device__ bool next(int i, Unit& u) const {
        const long L = (long)i * G + c; if (L >= nwg) return false;
        int wgid = (int)L; { const int q = nwg / NXCD, r = nwg % NXCD, xcd = wgid % NXCD, off = wgid / NXCD; wgid = (xcd < r ? xcd * (q + 1) : r * (q + 1) + (xcd - r) * q) + off; }
        const int nig = WGM * nN, gid = wgid / nig, fm = gid * WGM, gsz = (nM - fm) < WGM ? (nM - fm) : WGM;
        u.pm = fm + ((wgid % nig) % gsz); u.pn = (wgid % nig) / gsz; return true;
    }
    __device__ __forceinline__ void a_ready(const Unit&) const {}
    __device__ __forceinline__ void done(const Unit&) const {}
};
__device__ __forceinline__ unsigned cvt_pk_bf16(float lo, float hi) { unsigned r; asm volatile("v_cvt_pk_bf16_f32 %0, %1, %2" : "=v"(r) : "v"(lo), "v"(hi)); return r; }
typedef float f32x2 __attribute__((ext_vector_type(2)));
__device__ __forceinline__ f32x2 gelu_pk(f32x2 v) {
    const f32x2 av = __builtin_elementwise_abs(v), d = av * 0.2316418882f + 1.0f;
    f32x2 t; t.x = __builtin_amdgcn_rcpf(d.x); t.y = __builtin_amdgcn_rcpf(d.y);
    f32x2 q = t * 0.5307027145f + (-0.7265760135f); q = q * t + 0.7107068705f; q = q * t + (-0.142248368f); q = q * t + 0.127414796f; q = q * t;
    const f32x2 s = (v * v) * (-0.72134752044f);
    f32x2 e; e.x = __builtin_amdgcn_exp2f(s.x); e.y = __builtin_amdgcn_exp2f(s.y);
    const f32x2 m = v * (q * e), r = v - m;
    f32x2 o; o.x = v.x < 0.f ? m.x : r.x; o.y = v.y < 0.f ? m.y : r.y; return o;
}

struct EpiF32 {
    static constexpr bool PERM = false, AFTER_DRAIN = false;
    float* C; int ldc; const float* bias;
    __device__ __forceinline__ void operator()(const f32x4 (&acc)[2][2][4][2], const Unit& u, int wr, int wc, int fr, int fq) const {
        const int row0 = u.pm * BM + wr * 64 + fr, col0 = u.pn * BM + wc * 32 + 4 * fq;
        f32x4 bv[2][2];
#pragma unroll
        for (int bj = 0; bj < 2; ++bj)
#pragma unroll
            for (int n = 0; n < 2; ++n) bv[bj][n] = bias ? *(const f32x4*)(bias + col0 + bj * HALF + n * 16) : (f32x4){0.f, 0.f, 0.f, 0.f};
#pragma unroll
        for (int ai = 0; ai < 2; ++ai)
#pragma unroll
            for (int m = 0; m < 4; ++m) { float* rowp = C + (size_t)(row0 + ai * HALF + m * 16) * ldc + col0;
#pragma unroll
                for (int bj = 0; bj < 2; ++bj)
#pragma unroll
                    for (int n = 0; n < 2; ++n) *(f32x4*)(rowp + bj * HALF + n * 16) = acc[ai][bj][m][n] + bv[bj][n]; }
    }
};
template <int ACT  > struct EpiBf16 {
    static constexpr bool PERM = true, AFTER_DRAIN = false;
    bf16_t* O; int ldc; const float* bias; int split_cols; size_t split_stride;
    __device__ __forceinline__ void operator()(const f32x4 (&acc)[2][2][4][2], const Unit& u, int wr, int wc, int fr, int fq) const {
        const int row0 = u.pm * BM + wr * 64 + fr; int colt = u.pn * BM; bf16_t* base = O;
        if (split_cols) { const int t = colt / split_cols; base += (size_t)t * split_stride; colt -= t * split_cols; }
        const int col0 = colt + wc * 32 + 8 * fq, bcol0 = u.pn * BM + wc * 32 + 8 * fq;
        f32x4 bv[2][2];
#pragma unroll
        for (int bj = 0; bj < 2; ++bj)
#pragma unroll
            for (int n = 0; n < 2; ++n) bv[bj][n] = bias ? *(const f32x4*)(bias + bcol0 + bj * HALF + 4 * n) : (f32x4){0.f, 0.f, 0.f, 0.f};
#pragma unroll
        for (int ai = 0; ai < 2; ++ai)
#pragma unroll
            for (int m = 0; m < 4; ++m) { bf16_t* rowp = base + (size_t)(row0 + ai * HALF + m * 16) * ldc + col0;
#pragma unroll
                for (int bj = 0; bj < 2; ++bj) { f32x4 v0 = acc[ai][bj][m][0] + bv[bj][0], v1 = acc[ai][bj][m][1] + bv[bj][1];
                    if (ACT == 1) { f32x2 a = gelu_pk((f32x2){v0[0], v0[1]}), b = gelu_pk((f32x2){v0[2], v0[3]}), c = gelu_pk((f32x2){v1[0], v1[1]}), d = gelu_pk((f32x2){v1[2], v1[3]});
                        v0 = (f32x4){a.x, a.y, b.x, b.y}; v1 = (f32x4){c.x, c.y, d.x, d.y}; }
                    if (ACT == 2) {
#pragma unroll
                        for (int j = 0; j < 4; ++j) { v0[j] = 0.5f * v0[j] * (1.0f + erff(v0[j] * 0.70710678f)); v1[j] = 0.5f * v1[j] * (1.0f + erff(v1[j] * 0.70710678f)); } }
                    u32x4 w; w.x = cvt_pk_bf16(v0[0], v0[1]); w.y = cvt_pk_bf16(v0[2], v0[3]); w.z = cvt_pk_bf16(v1[0], v1[1]); w.w = cvt_pk_bf16(v1[2], v1[3]);
                    *(u32x4*)(rowp + bj * HALF) = w; } }
    }
};

template <class Epi, class Sched, bool STAMP = false>
__device__ __forceinline__ void gemm_phase(PG8_LAS unsigned char* lds, const Gemm g, const Sched& S, const Epi& E, unsigned long long* stamps) {
    int tid; asm volatile("v_mov_b32 %0, %1" : "=v"(tid) : "v"((int)threadIdx.x)); const int wid = __builtin_amdgcn_readfirstlane(tid >> 6), lane = tid & 63, wr = wid >> 2, wc = wid & 3, fr = lane & 15, fq = lane >> 4;
    const int K = g.K, nt = K / BK;
    int ts_lo = 0, ts_hi = 0, nts = 0; const unsigned long long rt_entry = STAMP ? (unsigned long long)wall_clock64() : 0ull;
#define PG8_STAMP() do { if (STAMP && wid == 0 && nts < 64) { const unsigned long long _c = (unsigned long long)clock64(); \
        ts_lo = (lane == nts) ? (int)(unsigned)_c : ts_lo; ts_hi = (lane == nts) ? (int)(unsigned)(_c >> 32) : ts_hi; ++nts; } } while (0)
    PG8_STAMP();
    unsigned voffA[2], voffB[2];
#pragma unroll
    for (int i = 0; i < 2; ++i) { int R, C; stage_rc(tid * 16 + i * 8192, R, C); const int Rb = Epi::PERM ? ((R & ~31) + perm32(R & 31)) : R;
        voffA[i] = (unsigned)(R * K + C) * 2u; voffB[i] = (unsigned)(Rb * K + C) * 2u; }
    const size_t kstep = (size_t)(BK * 2);
    const size_t hstep = (size_t)HALF * K * 2;
    const size_t tstep = 2 * hstep;
    const unsigned ldsw = (unsigned)wid * 1024u;
    const int aoff = lds_byte(wr * 64 + fr, fq * 8), boff = lds_byte(wc * 32 + fr, fq * 8);
#define PG8_SA(b, h) (((b) * 2 + (h)) * HTB)
#define PG8_SB(b, h) ((4 + (b) * 2 + (h)) * HTB)
#define PG8_STAGE(bufoff, gbase, voff) do { _Pragma("unroll") for (int _i = 0; _i < 2; ++_i) \
        __builtin_amdgcn_global_load_lds((const unsigned*)((const char*)(gbase) + (voff)[_i]), (PG8_LAS unsigned*)(lds + (bufoff) + ldsw + _i * 8192), 16, 0, 0); } while (0)
#define PG8_LDA(dst, b, h) do { _Pragma("unroll") for (int m = 0; m < 4; ++m) _Pragma("unroll") for (int k = 0; k < 2; ++k) dst[m][k] = *(const PG8_LAS bf16x8*)(lds + PG8_SA(b, h) + aoff + m * 2048 + k * 1024); } while (0)
#define PG8_LDB(dst, b, h) do { _Pragma("unroll") for (int n = 0; n < 2; ++n) _Pragma("unroll") for (int k = 0; k < 2; ++k) dst[n][k] = *(const PG8_LAS bf16x8*)(lds + PG8_SB(b, h) + boff + n * 2048 + k * 1024); } while (0)
#define PG8_MMA(ai, bj, At, Bt) do { __builtin_amdgcn_s_setprio(1); _Pragma("unroll") for (int m = 0; m < 4; ++m) _Pragma("unroll") for (int n = 0; n < 2; ++n) _Pragma("unroll") for (int k = 0; k < 2; ++k) \
        acc[ai][bj][m][n] = __builtin_amdgcn_mfma_f32_16x16x32_bf16(Bt[n][k], At[m][k], acc[ai][bj][m][n], 0, 0, 0); __builtin_amdgcn_s_setprio(0); } while (0)
#define PG8_WAIT_V(n) asm volatile("s_waitcnt vmcnt(" #n ")" ::: "memory")
#define PG8_WAIT_L(n) asm volatile("s_waitcnt lgkmcnt(" #n ")" ::: "memory")
#define PG8_BAR __builtin_amdgcn_s_barrier()
#define PG8_SCHED __builtin_amdgcn_sched_barrier(0)
    Unit cur, nxt; int ui = 0;
    if (!S.next(0, cur)) return;
    f32x4 acc[2][2][4][2];
#pragma unroll
    for (int a = 0; a < 2; ++a)
#pragma unroll
        for (int b = 0; b < 2; ++b)
#pragma unroll
            for (int m = 0; m < 4; ++m)
#pragma unroll
                for (int n = 0; n < 2; ++n) acc[a][b][m][n] = (f32x4){0.f, 0.f, 0.f, 0.f};
    bf16x8 At[4][2], B0[2][2], B1[2][2];
    const char* cA = (const char*)g.A + (size_t)cur.pm * tstep; const char* cB = (const char*)g.Bt + (size_t)cur.pn * tstep;
    S.a_ready(cur);
    PG8_STAGE(PG8_SB(0, 0), cB, voffB); PG8_STAGE(PG8_SA(0, 0), cA, voffA); PG8_STAGE(PG8_SB(0, 1), cB + hstep, voffB); PG8_STAGE(PG8_SA(0, 1), cA + hstep, voffA);
    if (wr == 1) PG8_BAR;
    PG8_WAIT_V(4); PG8_BAR;
    PG8_STAGE(PG8_SB(1, 0), cB + kstep, voffB); PG8_STAGE(PG8_SA(1, 0), cA + kstep, voffA); PG8_STAGE(PG8_SB(1, 1), cB + hstep + kstep, voffB);
    PG8_WAIT_V(6); PG8_BAR;
    PG8_STAMP();
    for (;;) {
        const bool has_next = S.next(ui + 1, nxt);
        const char* nA = has_next ? (const char*)g.A + (size_t)nxt.pm * tstep : cA; const char* nB = has_next ? (const char*)g.Bt + (size_t)nxt.pn * tstep : cB;
        for (int t = 0; t < nt; t += 2) {
            const bool last = (t == nt - 2);
            const char* a1 = cA + (size_t)(t + 1) * kstep;
            const char* a2 = last ? nA : cA + (size_t)(t + 2) * kstep; const char* b2 = last ? nB : cB + (size_t)(t + 2) * kstep;
            const char* a3 = a2 + kstep; const char* b3 = b2 + kstep;
            if (last && has_next) S.a_ready(nxt);
            PG8_LDB(B0, 0, 0); PG8_SCHED; PG8_LDA(At, 0, 0); PG8_STAGE(PG8_SA(1, 1), a1 + hstep, voffA);
            PG8_WAIT_L(8); PG8_BAR; PG8_WAIT_L(0); PG8_MMA(0, 0, At, B0); PG8_BAR; PG8_SCHED;
            PG8_LDB(B1, 0, 1); PG8_STAGE(PG8_SB(0, 0), b2, voffB);
            PG8_BAR; PG8_WAIT_L(0); PG8_MMA(0, 1, At, B1); PG8_BAR;
            PG8_LDA(At, 0, 1); PG8_STAGE(PG8_SA(0, 0), a2, voffA);
            PG8_BAR; PG8_WAIT_L(0); PG8_MMA(1, 0, At, B0); PG8_BAR; PG8_SCHED;
            PG8_STAGE(PG8_SB(0, 1), b2 + hstep, voffB);
            PG8_WAIT_V(6); PG8_BAR; PG8_MMA(1, 1, At, B1); PG8_BAR;
            PG8_LDB(B0, 1, 0); PG8_SCHED; PG8_LDA(At, 1, 0); PG8_STAGE(PG8_SA(0, 1), a2 + hstep, voffA);
            PG8_WAIT_L(8); PG8_BAR; PG8_WAIT_L(0); PG8_MMA(0, 0, At, B0); PG8_BAR; PG8_SCHED;
            PG8_LDB(B1, 1, 1); PG8_STAGE(PG8_SB(1, 0), b3, voffB);
            PG8_BAR; PG8_WAIT_L(0); PG8_MMA(0, 1, At, B1); PG8_BAR;
            PG8_LDA(At, 1, 1); PG8_STAGE(PG8_SA(1, 0), a3, voffA);
            PG8_BAR; PG8_WAIT_L(0); PG8_MMA(1, 0, At, B0); PG8_BAR; PG8_SCHED;
            PG8_STAGE(PG8_SB(1, 1), b3 + hstep, voffB);
            PG8_WAIT_V(6); PG8_BAR; PG8_MMA(1, 1, At, B1); PG8_BAR;
        }
        PG8_STAMP();
        if constexpr (!Epi::AFTER_DRAIN) { E(acc, cur, wr, wc, fr, fq); S.done(cur); }
        PG8_STAMP();
        if (!has_next) break;
#pragma unroll
        for (int a = 0; a < 2; ++a)
#pragma unroll
            for (int b = 0; b < 2; ++b)
#pragma unroll
                for (int m = 0; m < 4; ++m)
#pragma unroll
                    for (int n = 0; n < 2; ++n) acc[a][b][m][n] = (f32x4){0.f, 0.f, 0.f, 0.f};
        cur = nxt; cA = nA; cB = nB; ++ui;
    }
    PG8_WAIT_V(0);
    if (wr == 0) PG8_BAR;
    PG8_BAR;
    if constexpr (Epi::AFTER_DRAIN) { E.fused(acc, cur, wr, wc, fr, fq, lds, wid, lane); S.done(cur); }
    PG8_STAMP();
    if (STAMP && wid == 0) { stamps[lane] = lane < nts ? (((unsigned long long)(unsigned)ts_hi << 32) | (unsigned)ts_lo) : 0ull;
        if (lane == 62) stamps[62] = rt_entry; if (lane == 63) stamps[63] = (unsigned long long)wall_clock64(); }
#undef PG8_STAMP
#undef PG8_SA
#undef PG8_SB
#undef PG8_STAGE
#undef PG8_LDA
#undef PG8_LDB
#undef PG8_MMA
#undef PG8_WAIT_V
#undef PG8_WAIT_L
#undef PG8_BAR
#undef PG8_SCHED
}
}
#define DI __device__ __forceinline__
#define LAS __attribute__((address_space(3)))
typedef unsigned short bf16_t;
typedef short bf16x8 __attribute__((ext_vector_type(8)));
typedef float f32x4 __attribute__((ext_vector_type(4)));
typedef unsigned u32x4 __attribute__((ext_vector_type(4)));
typedef unsigned u32x2 __attribute__((ext_vector_type(2)));
typedef LAS unsigned char* ldsp;

constexpr int MTOK = 32768, DM = 1024, SEQ = 4096;
constexpr int DFF = 2816, NUP = 5632;
constexpr int MHALF = 16384;
constexpr size_t MiB = 1048576;
constexpr size_t OFF_WA_IN = 0, OFF_WA_OUT = 8 * MiB + MiB / 2, OFF_WB_IN = OFF_WA_OUT + 2 * MiB, OFF_WB_OUT = OFF_WB_IN + 3 * MiB;
constexpr size_t OFF_WUP0 = OFF_WB_OUT + 2 * MiB, OFF_WUP1 = OFF_WUP0 + 11 * MiB, OFF_WDN0 = OFF_WUP1 + 11 * MiB, OFF_WDN1 = OFF_WDN0 + 5 * MiB + MiB / 2;
constexpr size_t OFF_WG0 = OFF_WDN1 + 5 * MiB + MiB / 2, OFF_WG1 = OFF_WG0 + 2 * MiB, OFF_WP0 = OFF_WG1 + 2 * MiB, OFF_WP1 = OFF_WP0 + MiB / 2;
constexpr size_t OFF_SSA = 54 * MiB, OFF_SSB = 56 * MiB, OFF_BA = 58 * MiB;
constexpr size_t OFF_HB = 60 * MiB;
constexpr size_t OFF_XQ = 124 * MiB, OFF_XK = 188 * MiB, OFF_XV = 252 * MiB, OFF_XZ = 316 * MiB;
constexpr size_t OFF_YK = 380 * MiB, OFF_YV = 444 * MiB;
constexpr size_t OFF_GL = 508 * MiB;
constexpr size_t OFF_U = 124 * MiB, OFF_ACT = 300 * MiB, OFF_PB = 388 * MiB, OFF_PP = 404 * MiB;
constexpr size_t OFF_HB2 = 124 * MiB;
constexpr size_t OFF_BQ = 188 * MiB, OFF_BK = 252 * MiB, OFF_BV = 268 * MiB, OFF_AO = 284 * MiB;
constexpr size_t WS_NEED = 508 * MiB + 65536;
constexpr int LDS_BYTES = 147456;

struct Params { const float* in[20]; float* out; unsigned char* ws; };

DI unsigned char* opq(unsigned char* q) { asm volatile("" : "+s"(q)); return q; }
DI int otid() { int t; asm volatile("v_mov_b32 %0, %1" : "=v"(t) : "v"((int)threadIdx.x)); return t; }
DI float bf2f(bf16_t b) { return __uint_as_float(((unsigned)b) << 16); }
typedef __bf16 bf2_t __attribute__((ext_vector_type(2)));
DI unsigned pack2(float lo, float hi) { bf2_t v; v[0] = (__bf16)lo; v[1] = (__bf16)hi; return __builtin_bit_cast(unsigned, v); }
DI bf16_t f2bf(float f) { return __builtin_bit_cast(bf16_t, (__bf16)f); }
DI float lo2f(unsigned w) { return __uint_as_float(w << 16); }
DI float hi2f(unsigned w) { return __uint_as_float(w & 0xffff0000u); }
DI float wave_sum(float v) {
#pragma unroll
    for (int o = 32; o >= 1; o >>= 1) v += __shfl_xor(v, o);
    return v;
}
DI float sigmoidf_(float x) { return 1.0f / (1.0f + __expf(-x)); }
DI float siluf_(float x) { return x / (1.0f + __expf(-x)); }
DI float row_rstd(const float* __restrict__ ss, int row) {
    const f32x4* p = (const f32x4*)(ss + (size_t)row * 16);
    const f32x4 a = p[0], b = p[1], c = p[2], d = p[3];
    const float s = ((a[0] + a[1]) + (a[2] + a[3])) + ((b[0] + b[1]) + (b[2] + b[3])) + ((c[0] + c[1]) + (c[2] + c[3])) + ((d[0] + d[1]) + (d[2] + d[3]));
    return rsqrtf(s * (1.0f / 1024.0f) + 1e-6f);
}
#define MFMA16(a, b, c) __builtin_amdgcn_mfma_f32_16x16x32_bf16((a), (b), (c), 0, 0, 0)

using pg8::Unit;
struct EpiProjA {
    static constexpr bool PERM = true, AFTER_DRAIN = false;
    bf16_t* X; float* ba; const float* ss;
    DI void operator()(const f32x4 (&acc)[2][2][4][2], const Unit& u, int wr, int wc, int fr, int fq) const {
        const int row0 = u.pm * 256 + wr * 64 + fr;
        if (u.pn < 16) {
            bf16_t* base = X + (size_t)(u.pn >> 2) * ((size_t)MTOK * 1024);
            const int col0 = (u.pn & 3) * 256 + wc * 32 + 8 * fq;
#pragma unroll
            for (int ai = 0; ai < 2; ++ai)
#pragma unroll
                for (int m = 0; m < 4; ++m) {
                    const int row = row0 + ai * 128 + m * 16; const float rs = row_rstd(ss, row);
                    bf16_t* rowp = base + (size_t)row * 1024 + col0;
#pragma unroll
                    for (int bj = 0; bj < 2; ++bj) { const f32x4 v0 = acc[ai][bj][m][0] * rs, v1 = acc[ai][bj][m][1] * rs;
                        u32x4 w; w.x = pack2(v0[0], v0[1]); w.y = pack2(v0[2], v0[3]); w.z = pack2(v1[0], v1[1]); w.w = pack2(v1[2], v1[3]);
                        *(u32x4*)(rowp + bj * 128) = w; }
                }
        } else if (wc == 0 && fq < 2) {
#pragma unroll
            for (int ai = 0; ai < 2; ++ai)
#pragma unroll
                for (int m = 0; m < 4; ++m) {
                    const int row = row0 + ai * 128 + m * 16; const float rs = row_rstd(ss, row);
#pragma unroll
                    for (int n = 0; n < 2; ++n) *(f32x4*)(ba + (size_t)row * 16 + 8 * fq + 4 * n) = acc[ai][0][m][n] * rs;
                }
        }
    }
};
struct EpiProjB {
    static constexpr bool PERM = true, AFTER_DRAIN = false;
    bf16_t* Q; bf16_t* K; bf16_t* V; const float* ss;
    DI void operator()(const f32x4 (&acc)[2][2][4][2], const Unit& u, int wr, int wc, int fr, int fq) const {
        const int row0 = u.pm * 256 + wr * 64 + fr;
        bf16_t* base = u.pn < 4 ? Q + u.pn * 256 : (u.pn == 4 ? K : V);
        const int ld = u.pn < 4 ? 1024 : 256;
        const int col0 = wc * 32 + 8 * fq;
#pragma unroll
        for (int ai = 0; ai < 2; ++ai)
#pragma unroll
            for (int m = 0; m < 4; ++m) {
                const int row = row0 + ai * 128 + m * 16; const float rs = row_rstd(ss, row);
                bf16_t* rowp = base + (size_t)row * ld + col0;
#pragma unroll
                for (int bj = 0; bj < 2; ++bj) { const f32x4 v0 = acc[ai][bj][m][0] * rs, v1 = acc[ai][bj][m][1] * rs;
                    u32x4 w; w.x = pack2(v0[0], v0[1]); w.y = pack2(v0[2], v0[3]); w.z = pack2(v1[0], v1[1]); w.w = pack2(v1[2], v1[3]);
                    *(u32x4*)(rowp + bj * 128) = w; }
            }
    }
};
struct EpiUp {
    static constexpr bool PERM = true, AFTER_DRAIN = false;
    bf16_t* U; const float* ss; int rowbase;
    DI void operator()(const f32x4 (&acc)[2][2][4][2], const Unit& u, int wr, int wc, int fr, int fq) const {
        const int row0 = u.pm * 256 + wr * 64 + fr; const int col0 = u.pn * 256 + wc * 32 + 8 * fq;
#pragma unroll
        for (int ai = 0; ai < 2; ++ai)
#pragma unroll
            for (int m = 0; m < 4; ++m) {
                const int row = row0 + ai * 128 + m * 16; const float rs = row_rstd(ss, rowbase + row);
                bf16_t* rowp = U + (size_t)row * NUP + col0;
#pragma unroll
                for (int bj = 0; bj < 2; ++bj) { const f32x4 v0 = acc[ai][bj][m][0] * rs, v1 = acc[ai][bj][m][1] * rs;
                    u32x4 w; w.x = pack2(v0[0], v0[1]); w.y = pack2(v0[2], v0[3]); w.z = pack2(v1[0], v1[1]); w.w = pack2(v1[2], v1[3]);
                    *(u32x4*)(rowp + bj * 128) = w; }
            }
    }
};
struct EpiPlain {
    static constexpr bool PERM = false, AFTER_DRAIN = false;
    bf16_t* O;
    DI void operator()(const f32x4 (&acc)[2][2][4][2], const Unit& u, int wr, int wc, int fr, int fq) const {
        const int row0 = u.pm * 256 + wr * 64 + fr, col0 = u.pn * 256 + wc * 32 + 4 * fq;
#pragma unroll
        for (int ai = 0; ai < 2; ++ai)
#pragma unroll
            for (int m = 0; m < 4; ++m) { bf16_t* rowp = O + (size_t)(row0 + ai * 128 + m * 16) * 1024 + col0;
#pragma unroll
                for (int bj = 0; bj < 2; ++bj)
#pragma unroll
                    for (int n = 0; n < 2; ++n) { const f32x4 v = acc[ai][bj][m][n]; u32x2 w; w.x = pack2(v[0], v[1]); w.y = pack2(v[2], v[3]); *(u32x2*)(rowp + bj * 128 + n * 16) = w; }
            }
    }
};
struct EpiResidual {
    static constexpr bool PERM = false, AFTER_DRAIN = false;
    const float* hsrc; float* hdst; bf16_t* hb; float* ssout; int rowbase;
    DI void operator()(const f32x4 (&acc)[2][2][4][2], const Unit& u, int wr, int wc, int fr, int fq) const {
        const int row0 = rowbase + u.pm * 256 + wr * 64 + fr, col0 = u.pn * 256 + wc * 32 + 4 * fq;
#pragma unroll
        for (int ai = 0; ai < 2; ++ai)
#pragma unroll
            for (int m = 0; m < 4; ++m) {
                const int row = row0 + ai * 128 + m * 16; const size_t off = (size_t)row * 1024 + col0; float sq = 0.f;
#pragma unroll
                for (int bj = 0; bj < 2; ++bj)
#pragma unroll
                    for (int n = 0; n < 2; ++n) {
                        const f32x4 hv = *(const f32x4*)(hsrc + off + bj * 128 + n * 16); const f32x4 o = hv + acc[ai][bj][m][n];
                        *(f32x4*)(hdst + off + bj * 128 + n * 16) = o;
                        u32x2 w; w.x = pack2(o[0], o[1]); w.y = pack2(o[2], o[3]); *(u32x2*)(hb + off + bj * 128 + n * 16) = w;
                        sq += (o[0] * o[0] + o[1] * o[1]) + (o[2] * o[2] + o[3] * o[3]);
                    }
                sq += __shfl_xor(sq, 16); sq += __shfl_xor(sq, 32);
                if (fq == 0) ssout[(size_t)row * 16 + u.pn * 4 + wc] = sq;
            }
    }
};
struct EpiPle {
    static constexpr bool PERM = false, AFTER_DRAIN = false;
    float* h; bf16_t* hb; const bf16_t* pp; const float* ssin; float* ssout;
    DI void operator()(const f32x4 (&acc)[2][2][4][2], const Unit& u, int wr, int wc, int fr, int fq) const {
        const int row0 = u.pm * 256 + wr * 64 + fr, col0 = u.pn * 256 + wc * 32 + 4 * fq;
#pragma unroll
        for (int ai = 0; ai < 2; ++ai)
#pragma unroll
            for (int m = 0; m < 4; ++m) {
                const int row = row0 + ai * 128 + m * 16; const size_t off = (size_t)row * 1024 + col0; float sq = 0.f; const float rs = row_rstd(ssin, row);
#pragma unroll
                for (int bj = 0; bj < 2; ++bj)
#pragma unroll
                    for (int n = 0; n < 2; ++n) {
                        const size_t o2 = off + bj * 128 + n * 16;
                        const f32x4 hv = *(const f32x4*)(h + o2); const u32x2 pw = *(const u32x2*)(pp + o2); const f32x4 a = acc[ai][bj][m][n] * rs;
                        f32x4 o;
                        o[0] = hv[0] + sigmoidf_(a[0]) * lo2f(pw.x); o[1] = hv[1] + sigmoidf_(a[1]) * hi2f(pw.x);
                        o[2] = hv[2] + sigmoidf_(a[2]) * lo2f(pw.y); o[3] = hv[3] + sigmoidf_(a[3]) * hi2f(pw.y);
                        *(f32x4*)(h + o2) = o;
                        u32x2 w; w.x = pack2(o[0], o[1]); w.y = pack2(o[2], o[3]); *(u32x2*)(hb + o2) = w;
                        sq += (o[0] * o[0] + o[1] * o[1]) + (o[2] * o[2] + o[3] * o[3]);
                    }
                sq += __shfl_xor(sq, 16); sq += __shfl_xor(sq, 32);
                if (fq == 0) ssout[(size_t)row * 16 + u.pn * 4 + wc] = sq;
                asm volatile("" ::: "memory");
            }
    }
};

template <class Epi> DI void run_gemm(ldsp lds, const bf16_t* A, const bf16_t* Bt, int M, int N, int K, const Epi& E) {
    pg8::Gemm g; g.A = A; g.Bt = Bt; g.M = M; g.N = N; g.K = K;
    pg8::StaticOrder S; S.init(M, N, (int)gridDim.x, (int)blockIdx.x);
    pg8::gemm_phase<Epi, pg8::StaticOrder, false>(lds, g, S, E, nullptr);
}

DI void conv_w(const float* __restrict__ src, bf16_t* __restrict__ dst, const float* __restrict__ nw, int K, int N, int Npad, ldsp lds) {
    LAS float* tile = (LAS float*)lds;
    const int tid = otid();
    const int nkt = K / 64, ntile = nkt * (Npad / 64);
    for (int t = blockIdx.x; t < ntile; t += gridDim.x) {
        const int kt = t % nkt, nt = t / nkt, k0 = kt * 64, n0 = nt * 64;
#pragma unroll
        for (int i = 0; i < 2; ++i) {
            const int idx = tid + i * 512, r = idx >> 4, c4 = idx & 15, n = n0 + 4 * c4;
            f32x4 v = {0.f, 0.f, 0.f, 0.f};
            if (n < N) v = *(const f32x4*)(src + (size_t)(k0 + r) * N + n);
            const float s = nw ? nw[k0 + r] : 1.0f;
            tile[r * 65 + 4 * c4 + 0] = v[0] * s; tile[r * 65 + 4 * c4 + 1] = v[1] * s; tile[r * 65 + 4 * c4 + 2] = v[2] * s; tile[r * 65 + 4 * c4 + 3] = v[3] * s;
        }
        __syncthreads();
        { const int rn = tid >> 3, ck = tid & 7; u32x4 w;
          w.x = pack2(tile[(8 * ck + 0) * 65 + rn], tile[(8 * ck + 1) * 65 + rn]); w.y = pack2(tile[(8 * ck + 2) * 65 + rn], tile[(8 * ck + 3) * 65 + rn]);
          w.z = pack2(tile[(8 * ck + 4) * 65 + rn], tile[(8 * ck + 5) * 65 + rn]); w.w = pack2(tile[(8 * ck + 6) * 65 + rn], tile[(8 * ck + 7) * 65 + rn]);
          *(u32x4*)(dst + (size_t)(n0 + rn) * K + k0 + 8 * ck) = w; }
        __syncthreads();
    }
}
DI void phase_setup(const Params& p, ldsp lds) {
    unsigned char* ws = opq(p.ws);
    conv_w(p.in[6], (bf16_t*)(ws + OFF_WA_IN), p.in[2], 1024, 4112, 4352, lds);
    conv_w(p.in[11], (bf16_t*)(ws + OFF_WA_OUT), nullptr, 1024, 1024, 1024, lds);
    conv_w(p.in[12], (bf16_t*)(ws + OFF_WB_IN), p.in[2] + 1024, 1024, 1536, 1536, lds);
    conv_w(p.in[14], (bf16_t*)(ws + OFF_WB_OUT), nullptr, 1024, 1024, 1024, lds);
    conv_w(p.in[15], (bf16_t*)(ws + OFF_WUP0), p.in[3], 1024, NUP, NUP, lds);
    conv_w(p.in[15] + (size_t)1024 * NUP, (bf16_t*)(ws + OFF_WUP1), p.in[3] + 1024, 1024, NUP, NUP, lds);
    conv_w(p.in[17], (bf16_t*)(ws + OFF_WDN0), nullptr, DFF, 1024, 1024, lds);
    conv_w(p.in[17] + (size_t)DFF * 1024, (bf16_t*)(ws + OFF_WDN1), nullptr, DFF, 1024, 1024, lds);
    conv_w(p.in[19], (bf16_t*)(ws + OFF_WG0), p.in[4], 1024, 1024, 1024, lds);
    conv_w(p.in[19] + (size_t)1024 * 1024, (bf16_t*)(ws + OFF_WG1), p.in[4] + 1024, 1024, 1024, 1024, lds);
    conv_w(p.in[18], (bf16_t*)(ws + OFF_WP0), nullptr, 256, 1024, 1024, lds);
    conv_w(p.in[18] + (size_t)256 * 1024, (bf16_t*)(ws + OFF_WP1), nullptr, 256, 1024, 1024, lds);
    const int tid0 = otid(); const int lane = tid0 & 63, wid = tid0 >> 6;
    const float* x = p.in[0]; bf16_t* hb = (bf16_t*)(ws + OFF_HB); float* ssA = (float*)(ws + OFF_SSA);
    for (int row = blockIdx.x * 8 + wid; row < MTOK; row += gridDim.x * 8) {
        float sq = 0.f;
#pragma unroll
        for (int i = 0; i < 4; ++i) {
            const size_t off = (size_t)row * 1024 + i * 256 + lane * 4;
            const f32x4 v = *(const f32x4*)(x + off); sq += (v[0] * v[0] + v[1] * v[1]) + (v[2] * v[2] + v[3] * v[3]);
            u32x2 w; w.x = pack2(v[0], v[1]); w.y = pack2(v[2], v[3]); *(u32x2*)(hb + off) = w;
        }
        sq = wave_sum(sq);
        if (lane < 16) ssA[(size_t)row * 16 + lane] = lane == 0 ? sq : 0.f;
    }
}

DI void phase_conv_a(const Params& p) {
    unsigned char* ws = opq(p.ws);
    const int tid0 = otid(); const int lane = tid0 & 63, wid = tid0 >> 6;
    const float* aconv = p.in[7];
    for (int ui = blockIdx.x * 8 + wid; ui < 4096 * 3; ui += gridDim.x * 8) {
        const int tz = ui % 3, ch = ui / 3, n = ch & 63, bh = ch >> 6, h = bh & 7, b = bh >> 3;
        const bf16_t* X = (const bf16_t*)(ws + OFF_XQ) + (size_t)tz * ((size_t)MTOK * 1024);
        bf16_t* Y = (bf16_t*)(ws + (tz == 0 ? OFF_HB : (tz == 1 ? OFF_YK : OFF_YV))) + (size_t)ch * 8192;
        const int col = h * 128 + 2 * lane;
        float w[4][2];
#pragma unroll
        for (int i = 0; i < 4; ++i) { w[i][0] = aconv[i * 3072 + tz * 1024 + col]; w[i][1] = aconv[i * 3072 + tz * 1024 + col + 1]; }
        const size_t tok0 = (size_t)b * SEQ + n * 64;
        const unsigned* Xr = (const unsigned*)(X + tok0 * 1024 + col);
        float x0[2] = {0.f, 0.f}, x1[2] = {0.f, 0.f}, x2[2] = {0.f, 0.f};
        if (n > 0) { const unsigned a = *(Xr - 3 * 512), bb = *(Xr - 2 * 512), c = *(Xr - 512);
            x0[0] = lo2f(a); x0[1] = hi2f(a); x1[0] = lo2f(bb); x1[1] = hi2f(bb); x2[0] = lo2f(c); x2[1] = hi2f(c); }
        const float qs = tz == 0 ? 0.08838834764831845f : 1.0f;
        for (int i0 = 0; i0 < 64; i0 += 16) {
            unsigned cur[16];
#pragma unroll
            for (int i = 0; i < 16; ++i) cur[i] = Xr[(size_t)(i0 + i) * 512];
            float y0[16], y1[16];
#pragma unroll
            for (int i = 0; i < 16; ++i) {
                const float c0 = lo2f(cur[i]), c1 = hi2f(cur[i]);
                float a0 = w[0][0] * x0[0] + w[1][0] * x1[0] + w[2][0] * x2[0] + w[3][0] * c0;
                float a1 = w[0][1] * x0[1] + w[1][1] * x1[1] + w[2][1] * x2[1] + w[3][1] * c1;
                y0[i] = siluf_(a0); y1[i] = siluf_(a1);
                x0[0] = x1[0]; x0[1] = x1[1]; x1[0] = x2[0]; x1[1] = x2[1]; x2[0] = c0; x2[1] = c1;
            }
            if (tz < 2) {
#pragma unroll
                for (int i = 0; i < 16; ++i) { const float sq = wave_sum(y0[i] * y0[i] + y1[i] * y1[i]); const float r = rsqrtf(sq + 1e-6f) * qs; y0[i] *= r; y1[i] *= r; }
            }
#pragma unroll
            for (int i = 0; i < 16; ++i) *(unsigned*)(Y + (size_t)(i0 + i) * 128 + 2 * lane) = pack2(y0[i], y1[i]);
        }
    }
}

constexpr int PREP_HALF = 3 * 17408 + 16384 + 1280;
DI void phase_prep(const Params& p, ldsp lds0) {
    unsigned char* ws = opq(p.ws);
    const int tid = otid(), half = tid >> 8, lt = tid & 255, lw = lt >> 6, lane = tid & 63, fr = lane & 15, fq = lane >> 4;
    ldsp lds = lds0 + half * PREP_HALF;
    LAS bf16_t* sQ = (LAS bf16_t*)lds; LAS bf16_t* sK = (LAS bf16_t*)(lds + 17408); LAS bf16_t* sV = (LAS bf16_t*)(lds + 2 * 17408);
    LAS float* sL = (LAS float*)(lds + 3 * 17408); LAS float* sG = (LAS float*)(lds + 3 * 17408 + 16384);
    LAS float* gcs = sG; LAS float* sbeta = sG + 64; LAS float* egcs = sG + 128; LAS float* ek = sG + 192; LAS float* bk = sG + 256;
    const float* ba = (const float*)(ws + OFF_BA);
    for (int u0 = blockIdx.x * 2; u0 < 4096; u0 += gridDim.x * 2) {
        const int ch = u0 + half, n = ch & 63, bh = ch >> 6, h = bh & 7, b = bh >> 3;
        bf16_t* Yq = (bf16_t*)(ws + OFF_HB) + (size_t)ch * 8192; bf16_t* Yk = (bf16_t*)(ws + OFF_YK) + (size_t)ch * 8192; bf16_t* Yv = (bf16_t*)(ws + OFF_YV) + (size_t)ch * 8192;
        bf16_t* WK = (bf16_t*)(ws + OFF_XK) + (size_t)ch * 8192; bf16_t* QK = (bf16_t*)(ws + OFF_XV) + (size_t)ch * 4096;
#pragma unroll
        for (int ps = 0; ps < 4; ++ps) {
            const int idx = lt + ps * 256, row = idx >> 4, c8 = idx & 15;
            const u32x4 vq = *(const u32x4*)(Yq + row * 128 + 8 * c8), vk = *(const u32x4*)(Yk + row * 128 + 8 * c8), vv = *(const u32x4*)(Yv + row * 128 + 8 * c8);
            *(LAS u32x4*)(sQ + row * 136 + 8 * c8) = vq; *(LAS u32x4*)(sK + row * 136 + 8 * c8) = vk; *(LAS u32x4*)(sV + row * 136 + 8 * c8) = vv;
        }
        if (lw == 0) {
            const size_t tok = (size_t)b * SEQ + n * 64 + lane;
            const float bl = ba[tok * 16 + h], ain = ba[tok * 16 + 8 + h];
            const float beta = sigmoidf_(bl);
            const float xsp = ain + p.in[9][h];
            const float ey = __expf(xsp);
            const float sp = xsp > 20.f ? xsp : (ey < 0.01f ? ey * (1.0f - ey * (0.5f - ey * 0.33333333f)) : __logf(1.0f + ey));
            float g = -__expf(p.in[8][h]) * sp;
#pragma unroll
            for (int o = 1; o < 64; o <<= 1) { const float t = __shfl_up(g, o); if (lane >= o) g += t; }
            const float glast = __shfl(g, 63);
            const float eg = __expf(g);
            gcs[lane] = g; sbeta[lane] = beta; egcs[lane] = eg; ek[lane] = __expf(glast - g); bk[lane] = beta * eg;
        }
        __syncthreads();
        {
            const int mi = lw;
            bf16x8 ak[4], aq[4];
#pragma unroll
            for (int ks = 0; ks < 4; ++ks) { ak[ks] = *(const LAS bf16x8*)(sK + (16 * mi + fr) * 136 + 32 * ks + 8 * fq); aq[ks] = *(const LAS bf16x8*)(sQ + (16 * mi + fr) * 136 + 32 * ks + 8 * fq); }
#pragma unroll
            for (int nj = 0; nj < 4; ++nj) {
                f32x4 akk = {0.f, 0.f, 0.f, 0.f}, aqk = {0.f, 0.f, 0.f, 0.f};
                if (nj <= mi) {
#pragma unroll
                    for (int ks = 0; ks < 4; ++ks) { const bf16x8 bkf = *(const LAS bf16x8*)(sK + (16 * nj + fr) * 136 + 32 * ks + 8 * fq); akk = MFMA16(ak[ks], bkf, akk); aqk = MFMA16(aq[ks], bkf, aqk); }
                }
                const int jj = 16 * nj + fr; const float gj = gcs[jj];
#pragma unroll
                for (int j = 0; j < 4; ++j) {
                    const int i = 16 * mi + 4 * fq + j; const float gi = gcs[i];
                    const float dec = jj <= i ? __expf(gi - gj) : 0.f;
                    sL[i * 64 + jj] = jj < i ? sbeta[i] * akk[j] * dec : 0.f;
                    QK[i * 64 + jj] = f2bf(jj <= i ? aqk[j] * dec : 0.f);
                }
            }
        }
        __syncthreads();
        {
            const bool isv = lt < 128; const int cc = lt & 127;
            LAS bf16_t* srcT = isv ? sV : sK; LAS float* scl = isv ? sbeta : bk;
            float x[64];
#pragma unroll
            for (int i = 0; i < 64; ++i) x[i] = 0.f;
#pragma unroll
            for (int i = 0; i < 64; ++i) {
                const float r = bf2f(srcT[i * 136 + cc]) * scl[i];
                float s0 = 0.f, s1 = 0.f, s2 = 0.f, s3 = 0.f;
#pragma unroll
                for (int j4 = 0; j4 < (i + 3) / 4; ++j4) { const f32x4 l = *(const LAS f32x4*)(sL + i * 64 + 4 * j4);
                    s0 += l[0] * x[4 * j4]; s1 += l[1] * x[4 * j4 + 1]; s2 += l[2] * x[4 * j4 + 2]; s3 += l[3] * x[4 * j4 + 3];
                    if ((j4 & 3) == 3) asm volatile("" ::: "memory"); }
                x[i] = r - ((s0 + s1) + (s2 + s3));
                asm volatile("" ::: "memory");
            }
            if (isv) {
                bf16_t* dst = Yv + cc * 64;
#pragma unroll
                for (int g8 = 0; g8 < 8; ++g8) { u32x4 w; w.x = pack2(x[8 * g8], x[8 * g8 + 1]); w.y = pack2(x[8 * g8 + 2], x[8 * g8 + 3]); w.z = pack2(x[8 * g8 + 4], x[8 * g8 + 5]); w.w = pack2(x[8 * g8 + 6], x[8 * g8 + 7]);
                    *(u32x4*)(dst + 8 * g8) = w; }
            } else {
#pragma unroll
                for (int i = 0; i < 64; ++i) WK[i * 128 + cc] = f2bf(x[i]);
            }
        }
#pragma unroll
        for (int ps = 0; ps < 4; ++ps) {
            const int idx = lt + ps * 256;
            { const int row = idx >> 4, c8 = idx & 15; const float e = egcs[row]; const u32x4 v = *(const LAS u32x4*)(sQ + row * 136 + 8 * c8); u32x4 w;
              w.x = pack2(lo2f(v.x) * e, hi2f(v.x) * e); w.y = pack2(lo2f(v.y) * e, hi2f(v.y) * e); w.z = pack2(lo2f(v.z) * e, hi2f(v.z) * e); w.w = pack2(lo2f(v.w) * e, hi2f(v.w) * e);
              *(u32x4*)(Yq + row * 128 + 8 * c8) = w; }
            { const int d = idx >> 3, i8 = idx & 7; float v[8];
#pragma unroll
              for (int e = 0; e < 8; ++e) v[e] = bf2f(sK[(8 * i8 + e) * 136 + d]) * ek[8 * i8 + e];
              u32x4 w; w.x = pack2(v[0], v[1]); w.y = pack2(v[2], v[3]); w.z = pack2(v[4], v[5]); w.w = pack2(v[6], v[7]);
              *(u32x4*)(Yk + d * 64 + 8 * i8) = w; }
        }
        if (lt == 0) ((float*)(ws + OFF_GL))[ch] = egcs[63];
        __syncthreads();
    }
}

DI void phase_scan(const Params& p, ldsp lds) {
    unsigned char* ws = opq(p.ws);
    const int tid = otid(), wid = tid >> 6, lane = tid & 63, fr = lane & 15, fq = lane >> 4, mi = wid >> 1, ni = wid & 1;
    LAS bf16_t* sST = (LAS bf16_t*)lds;
    LAS bf16_t* sUT = (LAS bf16_t*)(lds + 32 * 272);
    for (int un = blockIdx.x; un < 256; un += gridDim.x) {
        const int sl = un & 3, bh = un >> 2, h = bh & 7, b = bh >> 3;
        const bf16_t* QD = (const bf16_t*)(ws + OFF_HB) + (size_t)bh * 64 * 8192;
        const bf16_t* KDT = (const bf16_t*)(ws + OFF_YK) + (size_t)bh * 64 * 8192;
        const bf16_t* U0T = (const bf16_t*)(ws + OFF_YV) + (size_t)bh * 64 * 8192;
        const bf16_t* WK = (const bf16_t*)(ws + OFF_XK) + (size_t)bh * 64 * 8192;
        const bf16_t* QK = (const bf16_t*)(ws + OFF_XV) + (size_t)bh * 64 * 4096;
        const float* GL = (const float*)(ws + OFF_GL) + bh * 64;
        bf16_t* O = (bf16_t*)(ws + OFF_XQ);
        for (int i = tid; i < 32 * 136 / 2; i += 512) ((LAS unsigned*)sST)[i] = 0u;
        f32x4 Sacc[2] = {{0.f, 0.f, 0.f, 0.f}, {0.f, 0.f, 0.f, 0.f}};
        bf16x8 wkf[4], qdf[4], qkf[2], kdf[2]; u32x2 u0f; float gl;
#define SCAN_LOAD(nn) do { \
            const bf16_t* wkp = WK + (size_t)(nn) * 8192 + (16 * mi + fr) * 128 + 8 * fq; const bf16_t* qdp = QD + (size_t)(nn) * 8192 + (16 * mi + fr) * 128 + 8 * fq; \
            _Pragma("unroll") for (int ks = 0; ks < 4; ++ks) { wkf[ks] = *(const bf16x8*)(wkp + 32 * ks); qdf[ks] = *(const bf16x8*)(qdp + 32 * ks); } \
            const bf16_t* qkp = QK + (size_t)(nn) * 4096 + (16 * mi + fr) * 64 + 8 * fq; const bf16_t* kdp = KDT + (size_t)(nn) * 8192 + (16 * wid + fr) * 64 + 8 * fq; \
            _Pragma("unroll") for (int ks = 0; ks < 2; ++ks) { qkf[ks] = *(const bf16x8*)(qkp + 32 * ks); kdf[ks] = *(const bf16x8*)(kdp + 32 * ks); } \
            u0f = *(const u32x2*)(U0T + (size_t)(nn) * 8192 + (sl * 32 + 16 * ni + fr) * 64 + 16 * mi + 4 * fq); gl = GL[nn]; } while (0)
        SCAN_LOAD(0);
        __syncthreads();
        for (int n = 0; n < 64; ++n) {
            bf16x8 cwk[4], cqd[4], cqk[2], ckd[2];
#pragma unroll
            for (int ks = 0; ks < 4; ++ks) { cwk[ks] = wkf[ks]; cqd[ks] = qdf[ks]; }
#pragma unroll
            for (int ks = 0; ks < 2; ++ks) { cqk[ks] = qkf[ks]; ckd[ks] = kdf[ks]; }
            const u32x2 cu0 = u0f; const float cgl = gl;
            if (n + 1 < 64) SCAN_LOAD(n + 1);
            f32x4 ua = {0.f, 0.f, 0.f, 0.f}, oa = {0.f, 0.f, 0.f, 0.f};
#pragma unroll
            for (int ks = 0; ks < 4; ++ks) { const bf16x8 st = *(const LAS bf16x8*)(sST + (16 * ni + fr) * 136 + 32 * ks + 8 * fq); ua = MFMA16(cwk[ks], st, ua); oa = MFMA16(cqd[ks], st, oa); }
            float uu[4];
            uu[0] = lo2f(cu0.x) - ua[0]; uu[1] = hi2f(cu0.x) - ua[1]; uu[2] = lo2f(cu0.y) - ua[2]; uu[3] = hi2f(cu0.y) - ua[3];
            { u32x2 w; w.x = pack2(uu[0], uu[1]); w.y = pack2(uu[2], uu[3]); *(LAS u32x2*)(sUT + (16 * ni + fr) * 72 + 16 * mi + 4 * fq) = w; }
            __syncthreads();
            bf16x8 ut0[2], ut1[2];
#pragma unroll
            for (int ks = 0; ks < 2; ++ks) { ut0[ks] = *(const LAS bf16x8*)(sUT + fr * 72 + 32 * ks + 8 * fq); ut1[ks] = *(const LAS bf16x8*)(sUT + (16 + fr) * 72 + 32 * ks + 8 * fq); }
#pragma unroll
            for (int ks = 0; ks < 2; ++ks) oa = MFMA16(cqk[ks], ni ? ut1[ks] : ut0[ks], oa);
            { bf16_t* op = O + ((size_t)b * SEQ + n * 64 + 16 * mi + 4 * fq) * 1024 + h * 128 + sl * 32 + 16 * ni + fr;
#pragma unroll
              for (int j = 0; j < 4; ++j) op[(size_t)j * 1024] = f2bf(oa[j]); }
            Sacc[0] *= cgl; Sacc[1] *= cgl;
#pragma unroll
            for (int ks = 0; ks < 2; ++ks) { Sacc[0] = MFMA16(ckd[ks], ut0[ks], Sacc[0]); Sacc[1] = MFMA16(ckd[ks], ut1[ks], Sacc[1]); }
#pragma unroll
            for (int nv = 0; nv < 2; ++nv) { u32x2 w; w.x = pack2(Sacc[nv][0], Sacc[nv][1]); w.y = pack2(Sacc[nv][2], Sacc[nv][3]); *(LAS u32x2*)(sST + (16 * nv + fr) * 136 + 16 * wid + 4 * fq) = w; }
            __syncthreads();
        }
#undef SCAN_LOAD
    }
}

DI void phase_gate(const Params& p) {
    unsigned char* ws = opq(p.ws);
    const int tid0 = otid(); const int lane = tid0 & 63, wid = tid0 >> 6;
    bf16_t* O = (bf16_t*)(ws + OFF_XQ); const bf16_t* Z = (const bf16_t*)(ws + OFF_XZ);
    const float* nw = p.in[10];
    float wv[16];
#pragma unroll
    for (int e = 0; e < 16; ++e) wv[e] = nw[(lane & 7) * 16 + e];
    for (int row = blockIdx.x * 8 + wid; row < MTOK; row += gridDim.x * 8) {
        const size_t off = (size_t)row * 1024 + lane * 16;
        const u32x4 o0 = *(const u32x4*)(O + off), o1 = *(const u32x4*)(O + off + 8), z0 = *(const u32x4*)(Z + off), z1 = *(const u32x4*)(Z + off + 8);
        float ov[16], zv[16];
        ov[0] = lo2f(o0.x); ov[1] = hi2f(o0.x); ov[2] = lo2f(o0.y); ov[3] = hi2f(o0.y); ov[4] = lo2f(o0.z); ov[5] = hi2f(o0.z); ov[6] = lo2f(o0.w); ov[7] = hi2f(o0.w);
        ov[8] = lo2f(o1.x); ov[9] = hi2f(o1.x); ov[10] = lo2f(o1.y); ov[11] = hi2f(o1.y); ov[12] = lo2f(o1.z); ov[13] = hi2f(o1.z); ov[14] = lo2f(o1.w); ov[15] = hi2f(o1.w);
        zv[0] = lo2f(z0.x); zv[1] = hi2f(z0.x); zv[2] = lo2f(z0.y); zv[3] = hi2f(z0.y); zv[4] = lo2f(z0.z); zv[5] = hi2f(z0.z); zv[6] = lo2f(z0.w); zv[7] = hi2f(z0.w);
        zv[8] = lo2f(z1.x); zv[9] = hi2f(z1.x); zv[10] = lo2f(z1.y); zv[11] = hi2f(z1.y); zv[12] = lo2f(z1.z); zv[13] = hi2f(z1.z); zv[14] = lo2f(z1.w); zv[15] = hi2f(z1.w);
        float sq = 0.f;
#pragma unroll
        for (int e = 0; e < 16; ++e) sq += ov[e] * ov[e];
        sq += __shfl_xor(sq, 1); sq += __shfl_xor(sq, 2); sq += __shfl_xor(sq, 4);
        const float rs = rsqrtf(sq * (1.0f / 128.0f) + 1e-6f);
        float r[16];
#pragma unroll
        for (int e = 0; e < 16; ++e) r[e] = ov[e] * rs * wv[e] * siluf_(zv[e]);
        u32x4 w0, w1;
        w0.x = pack2(r[0], r[1]); w0.y = pack2(r[2], r[3]); w0.z = pack2(r[4], r[5]); w0.w = pack2(r[6], r[7]);
        w1.x = pack2(r[8], r[9]); w1.y = pack2(r[10], r[11]); w1.z = pack2(r[12], r[13]); w1.w = pack2(r[14], r[15]);
        *(u32x4*)(O + off) = w0; *(u32x4*)(O + off + 8) = w1;
    }
}

DI void phase_act(const Params& p, int layer, int half) {
    unsigned char* ws = opq(p.ws);
    const bf16_t* U = (const bf16_t*)(ws + OFF_U); bf16_t* ACT = (bf16_t*)(ws + OFF_ACT);
    const float* cw = p.in[16] + (size_t)layer * 3 * NUP;
    const int gt = blockIdx.x * 512 + otid(), nth = gridDim.x * 512;
    for (int ui = gt; ui < 1024 * 352; ui += nth) {
        const int cgp = ui % 352, run = ui / 352, c0 = cgp * 8, r0 = run * 16;
        float wg[3][8], wvv[3][8];
#pragma unroll
        for (int i = 0; i < 3; ++i) {
            const f32x4 a = *(const f32x4*)(cw + i * NUP + c0), b = *(const f32x4*)(cw + i * NUP + c0 + 4), c = *(const f32x4*)(cw + i * NUP + DFF + c0), d = *(const f32x4*)(cw + i * NUP + DFF + c0 + 4);
#pragma unroll
            for (int e = 0; e < 4; ++e) { wg[i][e] = a[e]; wg[i][4 + e] = b[e]; wvv[i][e] = c[e]; wvv[i][4 + e] = d[e]; }
        }
        float g0[8], g1[8], v0[8], v1[8];
#pragma unroll
        for (int e = 0; e < 8; ++e) { g0[e] = 0.f; g1[e] = 0.f; v0[e] = 0.f; v1[e] = 0.f; }
        if ((r0 & (SEQ - 1)) != 0) {
            const u32x4 a = *(const u32x4*)(U + (size_t)(r0 - 2) * NUP + c0), b = *(const u32x4*)(U + (size_t)(r0 - 1) * NUP + c0);
            const u32x4 c = *(const u32x4*)(U + (size_t)(r0 - 2) * NUP + DFF + c0), d = *(const u32x4*)(U + (size_t)(r0 - 1) * NUP + DFF + c0);
            g0[0] = lo2f(a.x); g0[1] = hi2f(a.x); g0[2] = lo2f(a.y); g0[3] = hi2f(a.y); g0[4] = lo2f(a.z); g0[5] = hi2f(a.z); g0[6] = lo2f(a.w); g0[7] = hi2f(a.w);
            g1[0] = lo2f(b.x); g1[1] = hi2f(b.x); g1[2] = lo2f(b.y); g1[3] = hi2f(b.y); g1[4] = lo2f(b.z); g1[5] = hi2f(b.z); g1[6] = lo2f(b.w); g1[7] = hi2f(b.w);
            v0[0] = lo2f(c.x); v0[1] = hi2f(c.x); v0[2] = lo2f(c.y); v0[3] = hi2f(c.y); v0[4] = lo2f(c.z); v0[5] = hi2f(c.z); v0[6] = lo2f(c.w); v0[7] = hi2f(c.w);
            v1[0] = lo2f(d.x); v1[1] = hi2f(d.x); v1[2] = lo2f(d.y); v1[3] = hi2f(d.y); v1[4] = lo2f(d.z); v1[5] = hi2f(d.z); v1[6] = lo2f(d.w); v1[7] = hi2f(d.w);
        }
#pragma unroll 4
        for (int i = 0; i < 16; ++i) {
            const u32x4 a = *(const u32x4*)(U + (size_t)(r0 + i) * NUP + c0), c = *(const u32x4*)(U + (size_t)(r0 + i) * NUP + DFF + c0);
            float g2[8], v2[8];
            g2[0] = lo2f(a.x); g2[1] = hi2f(a.x); g2[2] = lo2f(a.y); g2[3] = hi2f(a.y); g2[4] = lo2f(a.z); g2[5] = hi2f(a.z); g2[6] = lo2f(a.w); g2[7] = hi2f(a.w);
            v2[0] = lo2f(c.x); v2[1] = hi2f(c.x); v2[2] = lo2f(c.y); v2[3] = hi2f(c.y); v2[4] = lo2f(c.z); v2[5] = hi2f(c.z); v2[6] = lo2f(c.w); v2[7] = hi2f(c.w);
            float r[8];
#pragma unroll
            for (int e = 0; e < 8; ++e) {
                const float gg = wg[0][e] * g0[e] + wg[1][e] * g1[e] + wg[2][e] * g2[e];
                const float vv = wvv[0][e] * v0[e] + wvv[1][e] * v1[e] + wvv[2][e] * v2[e];
                r[e] = siluf_(gg) * vv;
                g0[e] = g1[e]; g1[e] = g2[e]; v0[e] = v1[e]; v1[e] = v2[e];
            }
            u32x4 w; w.x = pack2(r[0], r[1]); w.y = pack2(r[2], r[3]); w.z = pack2(r[4], r[5]); w.w = pack2(r[6], r[7]);
            *(u32x4*)(ACT + (size_t)(r0 + i) * DFF + c0) = w;
        }
    }
    if (half == 0) {
        const float* ps = p.in[1] + (size_t)layer * MTOK * 256; bf16_t* pb = (bf16_t*)(ws + OFF_PB);
        for (size_t i = (size_t)gt * 8; i < (size_t)MTOK * 256; i += (size_t)nth * 8) {
            const f32x4 a = *(const f32x4*)(ps + i), b = *(const f32x4*)(ps + i + 4);
            u32x4 w; w.x = pack2(a[0], a[1]); w.y = pack2(a[2], a[3]); w.z = pack2(b[0], b[1]); w.w = pack2(b[2], b[3]);
            *(u32x4*)(pb + i) = w;
        }
    }
}

DI void phase_attn(const Params& p, ldsp lds) {
    unsigned char* ws = opq(p.ws);
    const int tid = otid(), wid = tid >> 6, lane = tid & 63, fr = lane & 15, fq = lane >> 4, gi = wid >> 1, qh = wid & 1;
    LAS bf16_t* sK = (LAS bf16_t*)lds; LAS bf16_t* sVT = (LAS bf16_t*)(lds + 36864); LAS bf16_t* sP = (LAS bf16_t*)(lds + 36864 + 33792 + wid * 8448);
    const bf16_t* Q = (const bf16_t*)(ws + OFF_BQ); const bf16_t* Kg = (const bf16_t*)(ws + OFF_BK); const bf16_t* Vg = (const bf16_t*)(ws + OFF_BV);
    bf16_t* AO = (bf16_t*)(ws + OFF_AO);
    for (int un = blockIdx.x; un < 1024; un += gridDim.x) {
        const int g = un & 3, nb = (un >> 2) & 31, b = un >> 7;
        const int hq = g * 4 + gi;
        const float slope = exp2f(-0.5f * (float)(hq + 1)), sink = p.in[13][hq];
        __syncthreads();
#pragma unroll
        for (int ps = 0; ps < 4; ++ps) {
            const int idx = tid + ps * 512, kj = idx >> 3, c8 = idx & 7;
            const int tk = (nb - 1) * 128 + kj;
            u32x4 kv = {0u, 0u, 0u, 0u}, vv = {0u, 0u, 0u, 0u};
            if (tk >= 0) { const size_t off = ((size_t)b * SEQ + tk) * 256 + g * 64 + 8 * c8; kv = *(const u32x4*)(Kg + off); vv = *(const u32x4*)(Vg + off); }
            *(LAS u32x4*)(sK + kj * 72 + 8 * c8) = kv;
            const unsigned vw[4] = {vv.x, vv.y, vv.z, vv.w};
#pragma unroll
            for (int e = 0; e < 4; ++e) { sVT[(8 * c8 + 2 * e) * 264 + kj] = (bf16_t)(vw[e] & 0xffffu); sVT[(8 * c8 + 2 * e + 1) * 264 + kj] = (bf16_t)(vw[e] >> 16); }
        }
        __syncthreads();
        for (int mt = 0; mt < 4; ++mt) {
            const int q0 = 64 * qh + 16 * mt;
            const bf16_t* qp = Q + ((size_t)b * SEQ + nb * 128 + q0 + fr) * 1024 + hq * 64 + 8 * fq;
            const bf16x8 qf0 = *(const bf16x8*)qp, qf1 = *(const bf16x8*)(qp + 32);
            f32x4 sc[16];
#pragma unroll
            for (int nt = 0; nt < 16; ++nt) {
                f32x4 a = {0.f, 0.f, 0.f, 0.f};
                const bf16x8 k0 = *(const LAS bf16x8*)(sK + (16 * nt + fr) * 72 + 8 * fq), k1 = *(const LAS bf16x8*)(sK + (16 * nt + fr) * 72 + 32 + 8 * fq);
                a = MFMA16(qf0, k0, a); a = MFMA16(qf1, k1, a); sc[nt] = a;
            }
            float mx[4] = {-1e30f, -1e30f, -1e30f, -1e30f};
#pragma unroll
            for (int nt = 0; nt < 16; ++nt) {
                const int kj = 16 * nt + fr;
#pragma unroll
                for (int j = 0; j < 4; ++j) {
                    const int qi = q0 + 4 * fq + j, dist = qi + 128 - kj;
                    const bool valid = dist >= 0 && dist < 128 && (nb > 0 || kj >= 128);
                    const float lg = valid ? sc[nt][j] * 0.125f - slope * (float)dist : -1e30f;
                    sc[nt][j] = lg; mx[j] = fmaxf(mx[j], lg);
                }
            }
            float sm[4];
#pragma unroll
            for (int j = 0; j < 4; ++j) {
                float m = mx[j];
                m = fmaxf(m, __shfl_xor(m, 1)); m = fmaxf(m, __shfl_xor(m, 2)); m = fmaxf(m, __shfl_xor(m, 4)); m = fmaxf(m, __shfl_xor(m, 8));
                m = fmaxf(m, sink); mx[j] = m; sm[j] = 0.f;
            }
#pragma unroll
            for (int nt = 0; nt < 16; ++nt)
#pragma unroll
                for (int j = 0; j < 4; ++j) { const float e = sc[nt][j] > -1e29f ? __expf(sc[nt][j] - mx[j]) : 0.f; sc[nt][j] = e; sm[j] += e; }
#pragma unroll
            for (int j = 0; j < 4; ++j) {
                float s = sm[j];
                s += __shfl_xor(s, 1); s += __shfl_xor(s, 2); s += __shfl_xor(s, 4); s += __shfl_xor(s, 8);
                sm[j] = 1.0f / (s + __expf(sink - mx[j]));
            }
#pragma unroll
            for (int nt = 0; nt < 16; ++nt)
#pragma unroll
                for (int j = 0; j < 4; ++j) sP[(4 * fq + j) * 264 + 16 * nt + fr] = f2bf(sc[nt][j] * sm[j]);
            asm volatile("s_waitcnt lgkmcnt(0)" ::: "memory");
            f32x4 oa[4] = {{0.f, 0.f, 0.f, 0.f}, {0.f, 0.f, 0.f, 0.f}, {0.f, 0.f, 0.f, 0.f}, {0.f, 0.f, 0.f, 0.f}};
#pragma unroll
            for (int ks = 0; ks < 8; ++ks) {
                const bf16x8 pf = *(const LAS bf16x8*)(sP + fr * 264 + 32 * ks + 8 * fq);
#pragma unroll
                for (int nd = 0; nd < 4; ++nd) { const bf16x8 vf = *(const LAS bf16x8*)(sVT + (16 * nd + fr) * 264 + 32 * ks + 8 * fq); oa[nd] = MFMA16(pf, vf, oa[nd]); }
            }
            asm volatile("s_waitcnt lgkmcnt(0)" ::: "memory");
            bf16_t* op = AO + ((size_t)b * SEQ + nb * 128 + q0 + 4 * fq) * 1024 + hq * 64 + fr;
#pragma unroll
            for (int nd = 0; nd < 4; ++nd)
#pragma unroll
                for (int j = 0; j < 4; ++j) op[(size_t)j * 1024 + 16 * nd] = f2bf(oa[nd][j]);
        }
    }
}

DI void phase_final(const Params& p, const float* ss) {
    const int tid0 = otid(); const int lane = tid0 & 63, wid = tid0 >> 6;
    const float* nw = p.in[5]; float* h = p.out;
    f32x4 wv[4];
#pragma unroll
    for (int i = 0; i < 4; ++i) wv[i] = *(const f32x4*)(nw + i * 256 + lane * 4);
    for (int row = blockIdx.x * 8 + wid; row < MTOK; row += gridDim.x * 8) {
        const float rs = row_rstd(ss, row);
#pragma unroll
        for (int i = 0; i < 4; ++i) { const size_t off = (size_t)row * 1024 + i * 256 + lane * 4; const f32x4 v = *(const f32x4*)(h + off); *(f32x4*)(h + off) = v * rs * wv[i]; }
    }
}

__global__ void __launch_bounds__(512, 2) hybrid_fwd(Params p) {
    extern __shared__ __attribute__((aligned(16))) unsigned char shm[];
    ldsp lds = (ldsp)shm;
    cg::grid_group grid = cg::this_grid();
    phase_setup(p, lds);
    grid.sync();
#pragma nounroll
    for (int layer = 0; layer < 2; ++layer) {
        unsigned char* ws = opq(p.ws);
        float* ssA = (float*)(ws + OFF_SSA); float* ssB = (float*)(ws + OFF_SSB);
        float* s0 = layer ? ssB : ssA; float* s1 = layer ? ssA : ssB;
        if (layer == 0) {
            { EpiProjA E; E.X = (bf16_t*)(ws + OFF_XQ); E.ba = (float*)(ws + OFF_BA); E.ss = s0;
              run_gemm(lds, (const bf16_t*)(ws + OFF_HB), (const bf16_t*)(ws + OFF_WA_IN), MTOK, 4352, 1024, E); }
            grid.sync();
            phase_conv_a(p);
            grid.sync();
            phase_prep(p, lds);
            grid.sync();
            phase_scan(p, lds);
            grid.sync();
            phase_gate(p);
            grid.sync();
        } else {
            { EpiProjB E; E.Q = (bf16_t*)(ws + OFF_BQ); E.K = (bf16_t*)(ws + OFF_BK); E.V = (bf16_t*)(ws + OFF_BV); E.ss = s0;
              run_gemm(lds, (const bf16_t*)(ws + OFF_HB2), (const bf16_t*)(ws + OFF_WB_IN), MTOK, 1536, 1024, E); }
            grid.sync();
            phase_attn(p, lds);
            grid.sync();
        }
        { EpiResidual E; E.hsrc = layer ? p.out : p.in[0]; E.hdst = p.out; E.hb = (bf16_t*)(ws + OFF_HB); E.ssout = s1; E.rowbase = 0;
          run_gemm(lds, (const bf16_t*)(ws + (layer ? OFF_AO : OFF_XQ)), (const bf16_t*)(ws + (layer ? OFF_WB_OUT : OFF_WA_OUT)), MTOK, 1024, 1024, E); }
        grid.sync();
        const bf16_t* wup = (const bf16_t*)(ws + (layer ? OFF_WUP1 : OFF_WUP0)); const bf16_t* wdn = (const bf16_t*)(ws + (layer ? OFF_WDN1 : OFF_WDN0));
#pragma nounroll
        for (int c = 0; c < 2; ++c) {
            { EpiUp E; E.U = (bf16_t*)(ws + OFF_U); E.ss = s1; E.rowbase = c * MHALF;
              run_gemm(lds, (const bf16_t*)(ws + OFF_HB) + (size_t)c * MHALF * 1024, wup, MHALF, NUP, 1024, E); }
            grid.sync();
            phase_act(p, layer, c);
            grid.sync();
            { EpiResidual E; E.hsrc = p.out; E.hdst = p.out; E.hb = (bf16_t*)(ws + OFF_HB); E.ssout = s0; E.rowbase = c * MHALF;
              run_gemm(lds, (const bf16_t*)(ws + OFF_ACT), wdn, MHALF, 1024, DFF, E); }
            grid.sync();
        }
        { EpiPlain E; E.O = (bf16_t*)(ws + OFF_PP);
          run_gemm(lds, (const bf16_t*)(ws + OFF_PB), (const bf16_t*)(ws + (layer ? OFF_WP1 : OFF_WP0)), MTOK, 1024, 256, E); }
        { EpiPle E; E.h = p.out; E.hb = (bf16_t*)(ws + OFF_HB2); E.pp = (const bf16_t*)(ws + OFF_PP); E.ssin = s0; E.ssout = s1;
          run_gemm(lds, (const bf16_t*)(ws + OFF_HB), (const bf16_t*)(ws + (layer ? OFF_WG1 : OFF_WG0)), MTOK, 1024, 1024, E); }
        grid.sync();
    }
    phase_final(p, (const float*)(opq(p.ws) + OFF_SSA));
}

extern "C" void kernel_launch(void* const* d_in, const int* in_sizes, int n_in, void* d_out, int out_size, void* d_ws, size_t ws_size, hipStream_t stream) {
    static int grid_blocks = 0;
    if (grid_blocks == 0) {
        if (n_in != 20 || out_size != MTOK * DM || ws_size < WS_NEED) { fprintf(stderr, "kernel_launch: unexpected shapes (n_in %d, out %d, ws %zu, need %zu)\n", n_in, out_size, ws_size, (size_t)WS_NEED); grid_blocks = -1; return; }
        int dev = 0, cus = 0, per_cu = 0;
        (void)hipGetDevice(&dev);
        (void)hipDeviceGetAttribute(&cus, hipDeviceAttributeMultiprocessorCount, dev);
        if (hipFuncSetAttribute((const void*)hybrid_fwd, hipFuncAttributeMaxDynamicSharedMemorySize, LDS_BYTES) != hipSuccess) { fprintf(stderr, "kernel_launch: hipFuncSetAttribute failed\n"); grid_blocks = -1; return; }
        if (hipOccupancyMaxActiveBlocksPerMultiprocessor(&per_cu, (const void*)hybrid_fwd, 512, LDS_BYTES) != hipSuccess || per_cu < 1) { fprintf(stderr, "kernel_launch: occupancy query failed (%d)\n", per_cu); (void)hipGetLastError(); per_cu = 1; }
        if (per_cu > 1) per_cu = 1;
        grid_blocks = cus * per_cu;
    }
    if (grid_blocks < 0) return;
    Params p{};
    for (int i = 0; i < 20; ++i) p.in[i] = (const float*)d_in[i];
    p.out = (float*)d_out; p.ws = (unsigned char*)d_ws;
    void* args[] = {&p};
    hipError_t e = hipLaunchCooperativeKernel((const void*)hybrid_fwd, dim3(grid_blocks), dim3(512), args, LDS_BYTES, stream);
    if (e != hipSuccess) fprintf(stderr, "cooperative launch failed: %s (grid %d)\n", hipGetErrorString(e), grid_blocks);
}
```

```cpp
#include <hip/hip_runtime.h>
#include <hip/hip_cooperative_groups.h>
#include <cstdio>
namespace cg = cooperative_groups;
namespace pg8 {
#define PG8_LAS __attribute__((address_space(3)))
typedef unsigned short bf16_t;
typedef short bf16x8 __attribute__((ext_vector_type(8)));
typedef float f32x4 __attribute__((ext_vector_type(4)));
typedef unsigned u32x4 __attribute__((ext_vector_type(4)));
constexpr int BM = 256, BK = 64, HALF = 128, HTB = HALF * BK * 2  , STAGE_BYTES = 8 * HTB, NXCD = 8, WGM = 8;

__host__ __device__ __forceinline__ int lds_byte(int r, int c) { const int st = (r >> 4) * 2 + (c >> 5), rr = r & 15, cc = c & 31, ob = rr * 64 + cc * 2; return st * 1024 + (ob ^ (((ob >> 9) & 1) << 5)); }
__host__ __device__ __forceinline__ void stage_rc(int b, int& R, int& C) { const int st = b / 1024, sb = b % 1024, swz = sb ^ (((sb >> 9) & 1) << 5); R = (st >> 1) * 16 + swz / 64; C = (st & 1) * 32 + (swz % 64) / 2; }
__host__ __device__ __forceinline__ int perm32(int rho) { const int n = rho >> 4, i = rho & 15; return 8 * (i >> 2) + 4 * n + (i & 3); }

struct Unit { int pm, pn; };
struct Gemm { const bf16_t* A; const bf16_t* Bt; int M, N, K; };

struct StaticOrder {
    int nM, nN, nwg, G, c;
    __host__ __device__ void init(int M, int N, int G_, int c_) { nM = M / BM; nN = N / BM; nwg = nM * nN; G = G_; c = c_; }
    __host__ __device__ bool next(int i, Unit& u) const {
        const long L = (long)i * G + c; if (L >= nwg) return false;
        int wgid = (int)L; { const int q = nwg / NXCD, r = nwg % NXCD, xcd = wgid % NXCD, off = wgid / NXCD; wgid = (xcd < r ? xcd * (q + 1) : r * (q + 1) + (xcd - r) * q) + off; }
        const int nig = WGM * nN, gid = wgid / nig, fm = gid * WGM, gsz = (nM - fm) < WGM ? (nM - fm) : WGM;
        u.pm = fm + ((wgid % nig) % gsz); u.pn = (wgid % nig) / gsz; return true;
    }
    __device__ __forceinline__ void a_ready(const Unit&) const {}
    __device__ __forceinline__ void done(const Unit&) const {}
};
__device__ __forceinline__ unsigned cvt_pk_bf16(float lo, float hi) { unsigned r; asm volatile("v_cvt_pk_bf16_f32 %0, %1, %2" : "=v"(r) : "v"(lo), "v"(hi)); return r; }
typedef float f32x2 __attribute__((ext_vector_type(2)));
__device__ __forceinline__ f32x2 gelu_pk(f32x2 v) {
    const f32x2 av = __builtin_elementwise_abs(v), d = av * 0.2316418882f + 1.0f;
    f32x2 t; t.x = __builtin_amdgcn_rcpf(d.x); t.y = __builtin_amdgcn_rcpf(d.y);
    f32x2 q = t * 0.5307027145f + (-0.7265760135f); q = q * t + 0.7107068705f; q = q * t + (-0.142248368f); q = q * t + 0.127414796f; q = q * t;
    const f32x2 s = (v * v) * (-0.72134752044f);
    f32x2 e; e.x = __builtin_amdgcn_exp2f(s.x); e.y = __builtin_amdgcn_exp2f(s.y);
    const f32x2 m = v * (q * e), r = v - m;
    f32x2 o; o.x = v.x < 0.f ? m.x : r.x; o.y = v.y < 0.f ? m.y : r.y; return o;
}

struct EpiF32 {
    static constexpr bool PERM = false, AFTER_DRAIN = false;
    float* C; int ldc; const float* bias;
    __device__ __forceinline__ void operator()(const f32x4 (&acc)[2][2][4][2], const Unit& u, int wr, int wc, int fr, int fq) const {
        const int row0 = u.pm * BM + wr * 64 + fr, col0 = u.pn * BM + wc * 32 + 4 * fq;
        f32x4 bv[2][2];
#pragma unroll
        for (int bj = 0; bj < 2; ++bj)
#pragma unroll
            for (int n = 0; n < 2; ++n) bv[bj][n] = bias ? *(const f32x4*)(bias + col0 + bj * HALF + n * 16) : (f32x4){0.f, 0.f, 0.f, 0.f};
#pragma unroll
        for (int ai = 0; ai < 2; ++ai)
#pragma unroll
            for (int m = 0; m < 4; ++m) { float* rowp = C + (size_t)(row0 + ai * HALF + m * 16) * ldc + col0;
#pragma unroll
                for (int bj = 0; bj < 2; ++bj)
#pragma unroll
                    for (int n = 0; n < 2; ++n) *(f32x4*)(rowp + bj * HALF + n * 16) = acc[ai][bj][m][n] + bv[bj][n]; }
    }
};
template <int ACT  > struct EpiBf16 {
    static constexpr bool PERM = true, AFTER_DRAIN = false;
    bf16_t* O; int ldc; const float* bias; int split_cols; size_t split_stride;
    __device__ __forceinline__ void operator()(const f32x4 (&acc)[2][2][4][2], const Unit& u, int wr, int wc, int fr, int fq) const {
        const int row0 = u.pm * BM + wr * 64 + fr; int colt = u.pn * BM; bf16_t* base = O;
        if (split_cols) { const int t = colt / split_cols; base += (size_t)t * split_stride; colt -= t * split_cols; }
        const int col0 = colt + wc * 32 + 8 * fq, bcol0 = u.pn * BM + wc * 32 + 8 * fq;
        f32x4 bv[2][2];
#pragma unroll
        for (int bj = 0; bj < 2; ++bj)
#pragma unroll
            for (int n = 0; n < 2; ++n) bv[bj][n] = bias ? *(const f32x4*)(bias + bcol0 + bj * HALF + 4 * n) : (f32x4){0.f, 0.f, 0.f, 0.f};
#pragma unroll
        for (int ai = 0; ai < 2; ++ai)
#pragma unroll
            for (int m = 0; m < 4; ++m) { bf16_t* rowp = base + (size_t)(row0 + ai * HALF + m * 16) * ldc + col0;
#pragma unroll
                for (int bj = 0; bj < 2; ++bj) { f32x4 v0 = acc[ai][bj][m][0] + bv[bj][0], v1 = acc[ai][bj][m][1] + bv[bj][1];
                    if (ACT == 1) { f32x2 a = gelu_pk((f32x2){v0[0], v0[1]}), b = gelu_pk((f32x2){v0[2], v0[3]}), c = gelu_pk((f32x2){v1[0], v1[1]}), d = gelu_pk((f32x2){v1[2], v1[3]});
                        v0 = (f32x4){a.x, a.y, b.x, b.y}; v1 = (f32x4){c.x, c.y, d.x, d.y}; }
                    if (ACT == 2) {
#pragma unroll
                        for (int j = 0; j < 4; ++j) { v0[j] = 0.5f * v0[j] * (1.0f + erff(v0[j] * 0.70710678f)); v1[j] = 0.5f * v1[j] * (1.0f + erff(v1[j] * 0.70710678f)); } }
                    u32x4 w; w.x = cvt_pk_bf16(v0[0], v0[1]); w.y = cvt_pk_bf16(v0[2], v0[3]); w.z = cvt_pk_bf16(v1[0], v1[1]); w.w = cvt_pk_bf16(v1[2], v1[3]);
                    *(u32x4*)(rowp + bj * HALF) = w; } }
    }
};

template <class Epi, class Sched, bool STAMP = false, int AMAP = 0>
__device__ __forceinline__ void gemm_phase(PG8_LAS unsigned char* lds, const Gemm g, const Sched& S, const Epi& E, unsigned long long* stamps, const int wvi) {
    int tid; asm volatile("v_mbcnt_lo_u32_b32 %0, -1, 0\n\tv_mbcnt_hi_u32_b32 %0, -1, %0\n\tv_lshl_add_u32 %0, %1, 6, %0" : "=&v"(tid) : "s"(wvi)); const int wid = __builtin_amdgcn_readfirstlane(tid >> 6), lane = tid & 63, wr = wid >> 2, wc = wid & 3, fr = lane & 15, fq = lane >> 4;
    const int K = g.K, nt = K / BK;
    int ts_lo = 0, ts_hi = 0, nts = 0; const unsigned long long rt_entry = STAMP ? (unsigned long long)wall_clock64() : 0ull;
#define PG8_STAMP() do { if (STAMP && wid == 0 && nts < 64) { const unsigned long long _c = (unsigned long long)clock64(); \
        ts_lo = (lane == nts) ? (int)(unsigned)_c : ts_lo; ts_hi = (lane == nts) ? (int)(unsigned)(_c >> 32) : ts_hi; ++nts; } } while (0)
    PG8_STAMP();
    unsigned voffA[2], voffB[2];
#pragma unroll
    for (int i = 0; i < 2; ++i) { int R, C; stage_rc(tid * 16 + i * 8192, R, C); const int Rb = Epi::PERM ? ((R & ~31) + perm32(R & 31)) : R;
        voffA[i] = AMAP == 1 ? (unsigned)((62 * (R >> 6) + (R & 63)) * K + C) * 2u : (AMAP == 2 ? (unsigned)((128 * (R >> 6) + (R & 63)) * K + C) * 2u : (unsigned)(R * K + C) * 2u); voffB[i] = (unsigned)(Rb * K + C) * 2u; }
    const size_t kstep = (size_t)(BK * 2);
    const size_t hstep = (size_t)HALF * K * 2;
    const size_t tstep = 2 * hstep;
    const size_t hstepA = AMAP == 1 ? (size_t)124 * K * 2 : (AMAP == 2 ? (size_t)64 * K * 2 : hstep), tstepA = AMAP == 1 ? 2 * hstepA : tstep;
    const unsigned ldsw = (unsigned)wid * 1024u;
    const int aoff = lds_byte(wr * 64 + fr, fq * 8), boff = lds_byte(wc * 32 + fr, fq * 8);
#define PG8_SA(b, h) (((b) * 2 + (h)) * HTB)
#define PG8_SB(b, h) ((4 + (b) * 2 + (h)) * HTB)
#define PG8_STAGE(bufoff, gbase, voff) do { _Pragma("unroll") for (int _i = 0; _i < 2; ++_i) \
        __builtin_amdgcn_global_load_lds((const unsigned*)((const char*)(gbase) + (voff)[_i]), (PG8_LAS unsigned*)(lds + (bufoff) + ldsw + _i * 8192), 16, 0, 0); } while (0)
#define PG8_LDA(dst, b, h) do { _Pragma("unroll") for (int m = 0; m < 4; ++m) _Pragma("unroll") for (int k = 0; k < 2; ++k) dst[m][k] = *(const PG8_LAS bf16x8*)(lds + PG8_SA(b, h) + aoff + m * 2048 + k * 1024); } while (0)
#define PG8_LDB(dst, b, h) do { _Pragma("unroll") for (int n = 0; n < 2; ++n) _Pragma("unroll") for (int k = 0; k < 2; ++k) dst[n][k] = *(const PG8_LAS bf16x8*)(lds + PG8_SB(b, h) + boff + n * 2048 + k * 1024); } while (0)
#define PG8_MMA(ai, bj, At, Bt) do { __builtin_amdgcn_s_setprio(1); _Pragma("unroll") for (int m = 0; m < 4; ++m) _Pragma("unroll") for (int n = 0; n < 2; ++n) _Pragma("unroll") for (int k = 0; k < 2; ++k) \
        acc[ai][bj][m][n] = __builtin_amdgcn_mfma_f32_16x16x32_bf16(Bt[n][k], At[m][k], acc[ai][bj][m][n], 0, 0, 0); __builtin_amdgcn_s_setprio(0); } while (0)
#define PG8_WAIT_V(n) asm volatile("s_waitcnt vmcnt(" #n ")" ::: "memory")
#define PG8_WAIT_L(n) asm volatile("s_waitcnt lgkmcnt(" #n ")" ::: "memory")
#define PG8_BAR __builtin_amdgcn_s_barrier()
#define PG8_SCHED __builtin_amdgcn_sched_barrier(0)
    Unit cur, nxt; int ui = 0;
    if (!S.next(0, cur)) return;
    f32x4 acc[2][2][4][2];
#pragma unroll
    for (int a = 0; a < 2; ++a)
#pragma unroll
        for (int b = 0; b < 2; ++b)
#pragma unroll
            for (int m = 0; m < 4; ++m)
#pragma unroll
                for (int n = 0; n < 2; ++n) acc[a][b][m][n] = (f32x4){0.f, 0.f, 0.f, 0.f};
    bf16x8 At[4][2], B0[2][2], B1[2][2];
    const char* cA = (const char*)g.A + (size_t)cur.pm * tstepA; const char* cB = (const char*)g.Bt + (size_t)cur.pn * tstep;
    S.a_ready(cur);
    PG8_STAGE(PG8_SB(0, 0), cB, voffB); PG8_STAGE(PG8_SA(0, 0), cA, voffA); PG8_STAGE(PG8_SB(0, 1), cB + hstep, voffB); PG8_STAGE(PG8_SA(0, 1), cA + hstepA, voffA);
    if (wr == 1) PG8_BAR;
    PG8_WAIT_V(4); PG8_BAR;
    PG8_STAGE(PG8_SB(1, 0), cB + kstep, voffB); PG8_STAGE(PG8_SA(1, 0), cA + kstep, voffA); PG8_STAGE(PG8_SB(1, 1), cB + hstep + kstep, voffB);
    PG8_WAIT_V(6); PG8_BAR;
    PG8_STAMP();
    for (;;) {
        const bool has_next = S.next(ui + 1, nxt);
        const char* nA = has_next ? (const char*)g.A + (size_t)nxt.pm * tstepA : cA; const char* nB = has_next ? (const char*)g.Bt + (size_t)nxt.pn * tstep : cB;
        for (int t = 0; t < nt; t += 2) {
            const bool last = (t == nt - 2);
            const char* a1 = cA + (size_t)(t + 1) * kstep;
            const char* a2 = last ? nA : cA + (size_t)(t + 2) * kstep; const char* b2 = last ? nB : cB + (size_t)(t + 2) * kstep;
            const char* a3 = a2 + kstep; const char* b3 = b2 + kstep;
            if (last && has_next) S.a_ready(nxt);
            PG8_LDB(B0, 0, 0); PG8_SCHED; PG8_LDA(At, 0, 0); PG8_STAGE(PG8_SA(1, 1), a1 + hstepA, voffA);
            PG8_WAIT_L(8); PG8_BAR; PG8_WAIT_L(0); PG8_MMA(0, 0, At, B0); PG8_BAR; PG8_SCHED;
            PG8_LDB(B1, 0, 1); PG8_STAGE(PG8_SB(0, 0), b2, voffB);
            PG8_BAR; PG8_WAIT_L(0); PG8_MMA(0, 1, At, B1); PG8_BAR;
            PG8_LDA(At, 0, 1); PG8_STAGE(PG8_SA(0, 0), a2, voffA);
            PG8_BAR; PG8_WAIT_L(0); PG8_MMA(1, 0, At, B0); PG8_BAR; PG8_SCHED;
            PG8_STAGE(PG8_SB(0, 1), b2 + hstep, voffB);
            PG8_WAIT_V(6); PG8_BAR; PG8_MMA(1, 1, At, B1); PG8_BAR;
            PG8_LDB(B0, 1, 0); PG8_SCHED; PG8_LDA(At, 1, 0); PG8_STAGE(PG8_SA(0, 1), a2 + hstepA, voffA);
            PG8_WAIT_L(8); PG8_BAR; PG8_WAIT_L(0); PG8_MMA(0, 0, At, B0); PG8_BAR; PG8_SCHED;
            PG8_LDB(B1, 1, 1); PG8_STAGE(PG8_SB(1, 0), b3, voffB);
            PG8_BAR; PG8_WAIT_L(0); PG8_MMA(0, 1, At, B1); PG8_BAR;
            PG8_LDA(At, 1, 1); PG8_STAGE(PG8_SA(1, 0), a3, voffA);
            PG8_BAR; PG8_WAIT_L(0); PG8_MMA(1, 0, At, B0); PG8_BAR; PG8_SCHED;
            PG8_STAGE(PG8_SB(1, 1), b3 + hstep, voffB);
            PG8_WAIT_V(6); PG8_BAR; PG8_MMA(1, 1, At, B1); PG8_BAR;
        }
        PG8_STAMP();
        if constexpr (!Epi::AFTER_DRAIN) { E(acc, cur, wr, wc, fr, fq); S.done(cur); }
        PG8_STAMP();
        if (!has_next) break;
#pragma unroll
        for (int a = 0; a < 2; ++a)
#pragma unroll
            for (int b = 0; b < 2; ++b)
#pragma unroll
                for (int m = 0; m < 4; ++m)
#pragma unroll
                    for (int n = 0; n < 2; ++n) acc[a][b][m][n] = (f32x4){0.f, 0.f, 0.f, 0.f};
        cur = nxt; cA = nA; cB = nB; ++ui;
    }
    PG8_WAIT_V(0);
    if (wr == 0) PG8_BAR;
    PG8_BAR;
    if constexpr (Epi::AFTER_DRAIN) { E.fused(acc, cur, wr, wc, fr, fq, lds, wid, lane); S.done(cur); }
    PG8_STAMP();
    if (STAMP && wid == 0) { stamps[lane] = lane < nts ? (((unsigned long long)(unsigned)ts_hi << 32) | (unsigned)ts_lo) : 0ull;
        if (lane == 62) stamps[62] = rt_entry; if (lane == 63) stamps[63] = (unsigned long long)wall_clock64(); }
#undef PG8_STAMP
#undef PG8_SA
#undef PG8_SB
#undef PG8_STAGE
#undef PG8_LDA
#undef PG8_LDB
#undef PG8_MMA
#undef PG8_WAIT_V
#undef PG8_WAIT_L
#undef PG8_BAR
#undef PG8_SCHED
}
}
#define DI __device__ __forceinline__
#define LAS __attribute__((address_space(3)))
typedef unsigned short bf16_t;
typedef short bf16x8 __attribute__((ext_vector_type(8)));
typedef float f32x4 __attribute__((ext_vector_type(4)));
typedef unsigned u32x4 __attribute__((ext_vector_type(4)));
typedef unsigned u32x2 __attribute__((ext_vector_type(2)));
typedef LAS unsigned char* ldsp;

constexpr int MTOK = 32768, DM = 1024, SEQ = 4096;
constexpr int DFF = 2816, NUP = 5632;
constexpr int MHALF = 16384;
constexpr size_t MiB = 1048576;
constexpr size_t OFF_WA_IN = 0, OFF_WA_OUT = 8 * MiB + MiB / 2, OFF_WB_IN = OFF_WA_OUT + 2 * MiB, OFF_WB_OUT = OFF_WB_IN + 3 * MiB;
constexpr size_t OFF_WUP0 = OFF_WB_OUT + 2 * MiB, OFF_WUP1 = OFF_WUP0 + 11 * MiB, OFF_WDN0 = OFF_WUP1 + 11 * MiB, OFF_WDN1 = OFF_WDN0 + 5 * MiB + MiB / 2;
constexpr size_t OFF_WG0 = OFF_WDN1 + 5 * MiB + MiB / 2, OFF_WG1 = OFF_WG0 + 2 * MiB, OFF_WP0 = OFF_WG1 + 2 * MiB, OFF_WP1 = OFF_WP0 + MiB / 2;
constexpr size_t OFF_SSA = 54 * MiB, OFF_SSB = 56 * MiB, OFF_BA = 58 * MiB;
constexpr size_t OFF_HB = 60 * MiB;
constexpr size_t OFF_XQ = 124 * MiB, OFF_XK = 188 * MiB, OFF_XV = 252 * MiB, OFF_XZ = 316 * MiB;
constexpr size_t OFF_YK = 380 * MiB, OFF_YV = 444 * MiB;
constexpr size_t OFF_GL = 508 * MiB;
constexpr size_t OFF_RAW = 300 * MiB;
constexpr size_t OFF_ACT = 124 * MiB, OFF_PB = 388 * MiB, OFF_PP = 404 * MiB;
constexpr size_t OFF_HB2 = 124 * MiB;
constexpr size_t OFF_BQ = 188 * MiB, OFF_BK = 252 * MiB, OFF_BV = 268 * MiB, OFF_AO = 284 * MiB;
constexpr size_t OFF_BAR = 510 * MiB;
constexpr size_t WS_NEED = 510 * MiB + 65536;
constexpr int LDS_ST_OFF = 147456 - 16;
constexpr int LDS_BYTES = 147456;

struct Params { const float* in[20]; float* out; unsigned char* ws; };

DI unsigned char* opq(unsigned char* q) { unsigned long long v = (unsigned long long)q; asm volatile("" : "+s"(v)); return (unsigned char*)(__attribute__((address_space(1))) unsigned char*)v; }
DI int otid(int wvi) { int t; asm volatile("v_mbcnt_lo_u32_b32 %0, -1, 0\n\tv_mbcnt_hi_u32_b32 %0, -1, %0\n\tv_lshl_add_u32 %0, %1, 6, %0" : "=&v"(t) : "s"(wvi)); return t; }
DI float bf2f(bf16_t b) { return __uint_as_float(((unsigned)b) << 16); }
typedef __bf16 bf2_t __attribute__((ext_vector_type(2)));
DI unsigned pack2(float lo, float hi) { bf2_t v; v[0] = (__bf16)lo; v[1] = (__bf16)hi; return __builtin_bit_cast(unsigned, v); }
DI bf16_t f2bf(float f) { return __builtin_bit_cast(bf16_t, (__bf16)f); }
DI float lo2f(unsigned w) { return __uint_as_float(w << 16); }
DI float hi2f(unsigned w) { return __uint_as_float(w & 0xffff0000u); }
DI float wave_sum(float v) {
#pragma unroll
    for (int o = 32; o >= 1; o >>= 1) v += __shfl_xor(v, o);
    return v;
}
DI void lds_barrier() { asm volatile("s_waitcnt lgkmcnt(0)" ::: "memory"); __builtin_amdgcn_s_barrier(); asm volatile("" ::: "memory"); }
DI float sigmoidf_(float x) { return __builtin_amdgcn_rcpf(1.0f + __expf(-x)); }
DI float siluf_(float x) { return x * __builtin_amdgcn_rcpf(1.0f + __expf(-x)); }
DI float row_rstd(const float* __restrict__ ss, int row) { return rsqrtf(ss[row] * (1.0f / 1024.0f) + 1e-6f); }
#define MFMA16(a, b, c) __builtin_amdgcn_mfma_f32_16x16x32_bf16((a), (b), (c), 0, 0, 0)

#define XB_TMO      128
#define XB_XCNT(j)  (256  + 64 * (j))
#define XB_XSUB(j)  (1280 + 64 * (j))
#define XB_XGEN(j)  (2304 + 64 * (j))
#define XB_TOP      3328
#define XB_TOPGEN   3392
#define XCD_BAR_WORDS 3456
#define XB_SPIN_CAP (1u << 18)

__device__ __forceinline__ unsigned xb_ld(unsigned* p)              { return __hip_atomic_load(p, __ATOMIC_RELAXED, __HIP_MEMORY_SCOPE_AGENT); }
__device__ __forceinline__ unsigned xb_add(unsigned* p, unsigned v) { return __hip_atomic_fetch_add(p, v, __ATOMIC_RELAXED, __HIP_MEMORY_SCOPE_AGENT); }
__device__ __forceinline__ unsigned xb_xcc_id() { return (unsigned)__builtin_amdgcn_s_getreg((3 << 11) | 20) & 0xFu; }
#define XB_SPIN(cond, bar) do { unsigned _sp = 0; while (cond) { __builtin_amdgcn_s_sleep(1); \
    if ((++_sp & 255u) == 0u) { if (xb_ld(&(bar)[XB_TMO])) break; if (_sp > XB_SPIN_CAP) { atomicAdd(&(bar)[XB_TMO], 1u); break; } } } } while (0)

struct XcdBarrier {
    unsigned* bar; unsigned x; int wave;
    volatile LAS unsigned* st;
};

__device__ __forceinline__ XcdBarrier xcd_barrier_post(unsigned* bar, volatile LAS unsigned* st) {
    XcdBarrier b; b.bar = bar; b.x = xb_xcc_id(); b.st = st; b.wave = __builtin_amdgcn_readfirstlane((int)(threadIdx.x >> 6));
    if (threadIdx.x == 0) (void)xb_add(&bar[XB_XCNT(b.x)], 1u);
    return b;
}
__device__ __forceinline__ void xcd_barrier_complete(unsigned* bar, unsigned x, unsigned& nloc, unsigned& nx) {
    const unsigned G = gridDim.x * gridDim.y * gridDim.z;
    unsigned sum, cnt, mine, sp = 0u;
    for (;;) {
        sum = 0u; cnt = 0u; mine = 0u;
#pragma unroll
        for (unsigned j = 0; j < 16; ++j) { const unsigned c = xb_ld(&bar[XB_XCNT(j)]); sum += c; cnt += (c > 0u) ? 1u : 0u; mine = (j == x) ? c : mine; }
        if (sum == G) break;
        __builtin_amdgcn_s_sleep(1);
        if ((++sp & 255u) == 0u) { if (xb_ld(&bar[XB_TMO])) break; if (sp > XB_SPIN_CAP) { atomicAdd(&bar[XB_TMO], 1u); break; } }
    }
    nloc = mine > 0u ? mine : 1u; nx = cnt > 0u ? cnt : 1u;
}

__device__ __forceinline__ void xcd_barrier(const XcdBarrier& b) {
    asm volatile("s_waitcnt vmcnt(0)" ::: "memory");
    __syncthreads();
    if (b.wave == 0 && __builtin_amdgcn_mbcnt_hi(~0u, __builtin_amdgcn_mbcnt_lo(~0u, 0u)) == 0u) {
        unsigned* bar = b.bar;
        __builtin_amdgcn_s_waitcnt(0);
        unsigned nloc = b.st[0], nx = b.st[1];
        if (nloc == 0u) { xcd_barrier_complete(bar, b.x, nloc, nx); b.st[0] = nloc; b.st[1] = nx; }
        const unsigned old = xb_add(&bar[XB_XSUB(b.x)], 1u);
        const unsigned gen = old / nloc;
        if (old + 1u == (gen + 1u) * nloc) {
            __builtin_amdgcn_fence(__ATOMIC_RELEASE, "agent");
            asm volatile("s_waitcnt vmcnt(0)" ::: "memory");
            const unsigned og = xb_add(&bar[XB_TOP], 1u);
            const unsigned tg = og / nx;
            if (og + 1u == (tg + 1u) * nx) xb_add(&bar[XB_TOPGEN], 1u);
            else XB_SPIN(xb_ld(&bar[XB_TOPGEN]) == tg, bar);
            __builtin_amdgcn_fence(__ATOMIC_ACQUIRE, "agent");
            xb_add(&bar[XB_XGEN(b.x)], 1u);
            asm volatile("s_waitcnt vmcnt(0)" ::: "memory");
        } else {
            XB_SPIN(xb_ld(&bar[XB_XGEN(b.x)]) == gen, bar);
            __builtin_amdgcn_fence(__ATOMIC_ACQUIRE, "agent");
            asm volatile("s_waitcnt vmcnt(0)" ::: "memory");
        }
    }
    __syncthreads();
}


using pg8::Unit;
struct EpiProjA {
    static constexpr bool PERM = true, AFTER_DRAIN = false;
    bf16_t* X; float* ba; const float* ss;
    DI void operator()(const f32x4 (&acc)[2][2][4][2], const Unit& u, int wr, int wc, int fr, int fq) const {
        const int row0 = u.pm * 256 + wr * 64 + fr;
        float rsv[2][4];
#pragma unroll
        for (int ai = 0; ai < 2; ++ai)
#pragma unroll
            for (int m = 0; m < 4; ++m) rsv[ai][m] = ss[row0 + ai * 128 + m * 16];
        bf16_t* base = X + (size_t)(u.pn >> 2) * ((size_t)MTOK * 1024);
        const int col0 = (u.pn & 3) * 256 + wc * 32 + 8 * fq;
#pragma unroll
        for (int ai = 0; ai < 2; ++ai)
#pragma unroll
            for (int m = 0; m < 4; ++m) {
                const int row = row0 + ai * 128 + m * 16; const float rs = rsqrtf(rsv[ai][m] * (1.0f / 1024.0f) + 1e-6f);
                bf16_t* rowp = base + (size_t)row * 1024 + col0;
#pragma unroll
                for (int bj = 0; bj < 2; ++bj) { const f32x4 v0 = acc[ai][bj][m][0] * rs, v1 = acc[ai][bj][m][1] * rs;
                    u32x4 w; w.x = pack2(v0[0], v0[1]); w.y = pack2(v0[2], v0[3]); w.z = pack2(v1[0], v1[1]); w.w = pack2(v1[2], v1[3]);
                    *(u32x4*)(rowp + bj * 128) = w; }
            }
    }
};
struct EpiProjB {
    static constexpr bool PERM = true, AFTER_DRAIN = false;
    bf16_t* Q; bf16_t* K; bf16_t* V; const float* ss;
    DI void operator()(const f32x4 (&acc)[2][2][4][2], const Unit& u, int wr, int wc, int fr, int fq) const {
        const int row0 = u.pm * 256 + wr * 64 + fr;
        float rsv[2][4];
#pragma unroll
        for (int ai = 0; ai < 2; ++ai)
#pragma unroll
            for (int m = 0; m < 4; ++m) rsv[ai][m] = ss[row0 + ai * 128 + m * 16];
        bf16_t* base = u.pn < 4 ? Q + u.pn * 256 : (u.pn == 4 ? K : V);
        const int ld = u.pn < 4 ? 1024 : 256;
        const int col0 = wc * 32 + 8 * fq;
#pragma unroll
        for (int ai = 0; ai < 2; ++ai)
#pragma unroll
            for (int m = 0; m < 4; ++m) {
                const int row = row0 + ai * 128 + m * 16; const float rs = rsqrtf(rsv[ai][m] * (1.0f / 1024.0f) + 1e-6f);
                bf16_t* rowp = base + (size_t)row * ld + col0;
#pragma unroll
                for (int bj = 0; bj < 2; ++bj) { const f32x4 v0 = acc[ai][bj][m][0] * rs, v1 = acc[ai][bj][m][1] * rs;
                    u32x4 w; w.x = pack2(v0[0], v0[1]); w.y = pack2(v0[2], v0[3]); w.z = pack2(v1[0], v1[1]); w.w = pack2(v1[2], v1[3]);
                    *(u32x4*)(rowp + bj * 128) = w; }
            }
    }
};
struct EpiUp {
    static constexpr bool PERM = true, AFTER_DRAIN = false;
    bf16_t* U; const float* ss; int rowbase;
    DI void operator()(const f32x4 (&acc)[2][2][4][2], const Unit& u, int wr, int wc, int fr, int fq) const {
        const int row0 = u.pm * 256 + wr * 64 + fr; const int col0 = u.pn * 256 + wc * 32 + 8 * fq;
#pragma unroll
        for (int ai = 0; ai < 2; ++ai)
#pragma unroll
            for (int m = 0; m < 4; ++m) {
                const int row = row0 + ai * 128 + m * 16; const float rs = row_rstd(ss, rowbase + row);
                bf16_t* rowp = U + (size_t)row * NUP + col0;
#pragma unroll
                for (int bj = 0; bj < 2; ++bj) { const f32x4 v0 = acc[ai][bj][m][0] * rs, v1 = acc[ai][bj][m][1] * rs;
                    u32x4 w; w.x = pack2(v0[0], v0[1]); w.y = pack2(v0[2], v0[3]); w.z = pack2(v1[0], v1[1]); w.w = pack2(v1[2], v1[3]);
                    *(u32x4*)(rowp + bj * 128) = w; }
            }
    }
};
DI float dpp_ror1(float x) { return __builtin_bit_cast(float, __builtin_amdgcn_update_dpp(0, __builtin_bit_cast(int, x), 0x121, 0xf, 0xf, false)); }
DI float dpp_ror2(float x) { return __builtin_bit_cast(float, __builtin_amdgcn_update_dpp(0, __builtin_bit_cast(int, x), 0x122, 0xf, 0xf, false)); }
DI float dpp_shr1(float old, float x) { return __builtin_bit_cast(float, __builtin_amdgcn_update_dpp(__builtin_bit_cast(int, old), __builtin_bit_cast(int, x), 0x111, 0xf, 0xf, false)); }
DI float dpp_shr2(float old, float x) { return __builtin_bit_cast(float, __builtin_amdgcn_update_dpp(__builtin_bit_cast(int, old), __builtin_bit_cast(int, x), 0x112, 0xf, 0xf, false)); }
struct EpiUpAct {
    static constexpr bool PERM = true, AFTER_DRAIN = false;
    bf16_t* ACT; const float* ss; const float* cw; float* RAW;
    template <bool SS> DI void run(const f32x4 (&acc)[2][2][4][2], const Unit& u, int wr, int wc, int fr, int fq) const {
        const int colg = u.pn * 128 + wc * 32 + 8 * fq;
        const int tb = u.pm * 256 + wr * 128 + fr;
        float* rawb = RAW + (size_t)((u.pm * 2 + wr) * 4) * NUP;
        float rs[2][4];
#pragma unroll
        for (int ai = 0; ai < 2; ++ai)
#pragma unroll
            for (int m = 0; m < 4; ++m) rs[ai][m] = ss[tb + ai * 64 + 16 * m];
        f32x4 wg[2][3], wv[2][3];
#pragma unroll
        for (int n = 0; n < 2; ++n)
#pragma unroll
            for (int i = 0; i < 3; ++i) { wg[n][i] = *(const f32x4*)(cw + i * NUP + colg + 4 * n); wv[n][i] = *(const f32x4*)(cw + i * NUP + DFF + colg + 4 * n); }
#pragma unroll
        for (int ai = 0; ai < 2; ++ai)
#pragma unroll
            for (int m = 0; m < 4; ++m) rs[ai][m] = rsqrtf(rs[ai][m] * (1.0f / 1024.0f) + 1e-6f);
        if (fr < 2) {
#pragma unroll
            for (int bj = 0; bj < 2; ++bj)
#pragma unroll
                for (int n = 0; n < 2; ++n) *(f32x4*)(rawb + (size_t)fr * NUP + bj * DFF + colg + 4 * n) = acc[0][bj][0][n] * rs[0][0];
        }
        if (fr >= 14) {
#pragma unroll
            for (int bj = 0; bj < 2; ++bj)
#pragma unroll
                for (int n = 0; n < 2; ++n) *(f32x4*)(rawb + (size_t)(fr - 12) * NUP + bj * DFF + colg + 4 * n) = acc[1][bj][3][n] * rs[1][3];
        }
#pragma unroll
        for (int n = 0; n < 2; ++n) {
#pragma unroll
            for (int ai = 0; ai < 2; ++ai) {
                const int t0 = tb + ai * 64;
                float res[4][4];
#pragma unroll
                for (int j = 0; j < 4; ++j) {
                    float g[4], v[4];
                    float gp = 0.f, vp = 0.f;
#pragma unroll
                    for (int m = 0; m < 4; ++m) { g[m] = acc[ai][0][m][n][j] * rs[ai][m]; v[m] = acc[ai][1][m][n][j] * rs[ai][m]; }
                    if (ai == 1) { gp = acc[0][0][3][n][j] * rs[0][3]; vp = acc[0][1][3][n][j] * rs[0][3]; }
                    asm volatile("" : "+v"(g[0]), "+v"(g[1]), "+v"(g[2]), "+v"(g[3]), "+v"(v[0]), "+v"(v[1]), "+v"(v[2]), "+v"(v[3]), "+v"(gp), "+v"(vp));
                    float og1 = dpp_ror1(gp), og2 = dpp_ror2(gp), ov1 = dpp_ror1(vp), ov2 = dpp_ror2(vp);
#pragma unroll
                    for (int m = 0; m < 4; ++m) {
                        float pg1 = dpp_shr1(og1, g[m]), pg2 = dpp_shr2(og2, g[m]), pv1 = dpp_shr1(ov1, v[m]), pv2 = dpp_shr2(ov2, v[m]);
                        if (m < 3) { og1 = dpp_ror1(g[m]); og2 = dpp_ror2(g[m]); ov1 = dpp_ror1(v[m]); ov2 = dpp_ror2(v[m]); }
                        if (SS) { const int ts = (t0 + 16 * m) & (SEQ - 1);
                            if (ts < 1) { pg1 = 0.f; pv1 = 0.f; }
                            if (ts < 2) { pg2 = 0.f; pv2 = 0.f; } }
                        const float gate = wg[n][0][j] * pg2 + wg[n][1][j] * pg1 + wg[n][2][j] * g[m];
                        const float val = wv[n][0][j] * pv2 + wv[n][1][j] * pv1 + wv[n][2][j] * v[m];
                        res[m][j] = siluf_(gate) * val;
                    }
                    asm volatile("" : "+v"(res[0][j]), "+v"(res[1][j]), "+v"(res[2][j]), "+v"(res[3][j]));
                }
#pragma unroll
                for (int m = 0; m < 4; ++m) { const int tt = t0 + 16 * m; u32x2 w; w.x = pack2(res[m][0], res[m][1]); w.y = pack2(res[m][2], res[m][3]);
                    if (ai > 0 || m > 0 || fr >= 2) *(u32x2*)(ACT + (size_t)tt * DFF + colg + 4 * n) = w; }
            }
        }
    }
    DI void operator()(const f32x4 (&acc)[2][2][4][2], const Unit& u, int wr, int wc, int fr, int fq) const {
        run<true>(acc, u, wr, wc, fr, fq);
    }
};
DI void ffn_fixup_panel(const Params& p, int layer, int pm, const float* ss, int wvi) {
    unsigned char* ws = opq(p.ws);
    const float* RAW = (const float*)(ws + OFF_RAW); bf16_t* ACT = (bf16_t*)(ws + OFF_ACT); const float* cw = p.in[16] + (size_t)layer * 3 * NUP;
    for (int idx = otid(wvi); idx < DFF; idx += 512) {
        const int q = idx / (DFF / 4), c = (idx - q * (DFF / 4)) * 4, wr = q >> 1, r = q & 1;
        const int blk = pm * 2 + wr, t = blk * 128 + r, ts = t & (SEQ - 1);
        const float* cur = RAW + (size_t)(blk * 4 + r) * NUP;
        const float* p1 = r ? RAW + (size_t)(blk * 4) * NUP : RAW + (size_t)((blk - 1) * 4 + 3) * NUP;
        const float* p2 = r ? RAW + (size_t)((blk - 1) * 4 + 3) * NUP : RAW + (size_t)((blk - 1) * 4 + 2) * NUP;
        const f32x4 zero = {0.f, 0.f, 0.f, 0.f};
        const f32x4 g0 = *(const f32x4*)(cur + c), v0 = *(const f32x4*)(cur + DFF + c);
        f32x4 g1 = zero, v1 = zero, g2 = zero, v2 = zero;
        if (ts >= 1) { g1 = *(const f32x4*)(p1 + c); v1 = *(const f32x4*)(p1 + DFF + c); }
        if (ts >= 2) { g2 = *(const f32x4*)(p2 + c); v2 = *(const f32x4*)(p2 + DFF + c); }
        const f32x4 wg0 = *(const f32x4*)(cw + c), wg1 = *(const f32x4*)(cw + NUP + c), wg2 = *(const f32x4*)(cw + 2 * NUP + c);
        const f32x4 wv0 = *(const f32x4*)(cw + DFF + c), wv1 = *(const f32x4*)(cw + NUP + DFF + c), wv2 = *(const f32x4*)(cw + 2 * NUP + DFF + c);
        const f32x4 gate = wg0 * g2 + wg1 * g1 + wg2 * g0, val = wv0 * v2 + wv1 * v1 + wv2 * v0;
        u32x2 w; w.x = pack2(siluf_(gate[0]) * val[0], siluf_(gate[1]) * val[1]); w.y = pack2(siluf_(gate[2]) * val[2], siluf_(gate[3]) * val[3]);
        *(u32x2*)(ACT + (size_t)t * DFF + c) = w;
    }
}
struct EpiPlain {
    static constexpr bool PERM = false, AFTER_DRAIN = false;
    bf16_t* O;
    DI void operator()(const f32x4 (&acc)[2][2][4][2], const Unit& u, int wr, int wc, int fr, int fq) const {
        const int row0 = u.pm * 256 + wr * 64 + fr, col0 = u.pn * 256 + wc * 32 + 4 * fq;
#pragma unroll
        for (int ai = 0; ai < 2; ++ai)
#pragma unroll
            for (int m = 0; m < 4; ++m) { bf16_t* rowp = O + (size_t)(row0 + ai * 128 + m * 16) * 1024 + col0;
#pragma unroll
                for (int bj = 0; bj < 2; ++bj)
#pragma unroll
                    for (int n = 0; n < 2; ++n) { const f32x4 v = acc[ai][bj][m][n]; u32x2 w; w.x = pack2(v[0], v[1]); w.y = pack2(v[2], v[3]); *(u32x2*)(rowp + bj * 128 + n * 16) = w; }
            }
    }
};
struct EpiResidual {
    static constexpr bool PERM = false, AFTER_DRAIN = false;
    const float* hsrc; float* hdst; bf16_t* hb; float* ssout; int rowbase;
    DI void operator()(const f32x4 (&acc)[2][2][4][2], const Unit& u, int wr, int wc, int fr, int fq) const {
        const int row0 = rowbase + u.pm * 256 + wr * 64 + fr, col0 = u.pn * 256 + wc * 32 + 4 * fq;
#pragma unroll
        for (int ai = 0; ai < 2; ++ai)
#pragma unroll
            for (int mp = 0; mp < 2; ++mp) {
                f32x4 hv[2][2][2];
#pragma unroll
                for (int mm = 0; mm < 2; ++mm)
#pragma unroll
                    for (int bj = 0; bj < 2; ++bj)
#pragma unroll
                        for (int n = 0; n < 2; ++n) hv[mm][bj][n] = *(const f32x4*)(hsrc + (size_t)(row0 + ai * 128 + (2 * mp + mm) * 16) * 1024 + col0 + bj * 128 + n * 16);
#pragma unroll
                for (int mm = 0; mm < 2; ++mm) {
                    const int m = 2 * mp + mm, row = row0 + ai * 128 + m * 16; const size_t off = (size_t)row * 1024 + col0; float sq = 0.f;
#pragma unroll
                    for (int bj = 0; bj < 2; ++bj)
#pragma unroll
                        for (int n = 0; n < 2; ++n) {
                            const f32x4 o = hv[mm][bj][n] + acc[ai][bj][m][n];
                            *(f32x4*)(hdst + off + bj * 128 + n * 16) = o;
                            u32x2 w; w.x = pack2(o[0], o[1]); w.y = pack2(o[2], o[3]); *(u32x2*)(hb + off + bj * 128 + n * 16) = w;
                            sq += (o[0] * o[0] + o[1] * o[1]) + (o[2] * o[2] + o[3] * o[3]);
                        }
                    sq += __shfl_xor(sq, 16); sq += __shfl_xor(sq, 32);
                    if (fq == 0) unsafeAtomicAdd(ssout + row, sq);
                }
            }
    }
};
struct EpiPle {
    static constexpr bool PERM = false, AFTER_DRAIN = false;
    float* h; bf16_t* hb; const bf16_t* pp; const float* ssin; float* ssout;
    DI void operator()(const f32x4 (&acc)[2][2][4][2], const Unit& u, int wr, int wc, int fr, int fq) const {
        const int row0 = u.pm * 256 + wr * 64 + fr, col0 = u.pn * 256 + wc * 32 + 4 * fq;
#pragma unroll
        for (int ai = 0; ai < 2; ++ai)
#pragma unroll
            for (int mp = 0; mp < 2; ++mp) {
                f32x4 hv[2][2][2]; u32x2 pw[2][2][2]; float rsv[2];
#pragma unroll
                for (int mm = 0; mm < 2; ++mm) {
                    const int row = row0 + ai * 128 + (2 * mp + mm) * 16; rsv[mm] = ssin[row];
#pragma unroll
                    for (int bj = 0; bj < 2; ++bj)
#pragma unroll
                        for (int n = 0; n < 2; ++n) { const size_t o2 = (size_t)row * 1024 + col0 + bj * 128 + n * 16; hv[mm][bj][n] = *(const f32x4*)(h + o2); pw[mm][bj][n] = *(const u32x2*)(pp + o2); }
                }
#pragma unroll
                for (int mm = 0; mm < 2; ++mm) {
                    const int m = 2 * mp + mm, row = row0 + ai * 128 + m * 16; const size_t off = (size_t)row * 1024 + col0; float sq = 0.f;
                    const float rs = rsqrtf(rsv[mm] * (1.0f / 1024.0f) + 1e-6f);
#pragma unroll
                    for (int bj = 0; bj < 2; ++bj)
#pragma unroll
                        for (int n = 0; n < 2; ++n) {
                            const size_t o2 = off + bj * 128 + n * 16;
                            const f32x4 a = acc[ai][bj][m][n] * rs; const f32x4 hvv = hv[mm][bj][n]; const u32x2 pww = pw[mm][bj][n];
                            f32x4 o;
                            o[0] = hvv[0] + sigmoidf_(a[0]) * lo2f(pww.x); o[1] = hvv[1] + sigmoidf_(a[1]) * hi2f(pww.x);
                            o[2] = hvv[2] + sigmoidf_(a[2]) * lo2f(pww.y); o[3] = hvv[3] + sigmoidf_(a[3]) * hi2f(pww.y);
                            *(f32x4*)(h + o2) = o;
                            u32x2 w; w.x = pack2(o[0], o[1]); w.y = pack2(o[2], o[3]); *(u32x2*)(hb + o2) = w;
                            sq += (o[0] * o[0] + o[1] * o[1]) + (o[2] * o[2] + o[3] * o[3]);
                        }
                    sq += __shfl_xor(sq, 16); sq += __shfl_xor(sq, 32);
                    if (fq == 0) unsafeAtomicAdd(ssout + row, sq);
                }
            }
    }
};

template <class Epi> DI void run_gemm_amap(ldsp lds, int wvi, const bf16_t* A, const bf16_t* Bt, int Mtiles, int N, int K, const Epi& E) {
    pg8::Gemm g; g.A = A; g.Bt = Bt; g.M = Mtiles * 256; g.N = N; g.K = K;
    pg8::StaticOrder S; S.init(Mtiles * 256, N, (int)gridDim.x, (int)blockIdx.x);
    pg8::gemm_phase<Epi, pg8::StaticOrder, false, 2>(lds, g, S, E, nullptr, wvi);
}
template <class Epi> DI void run_gemm(ldsp lds, int wvi, const bf16_t* A, const bf16_t* Bt, int M, int N, int K, const Epi& E) {
    pg8::Gemm g; g.A = A; g.Bt = Bt; g.M = M; g.N = N; g.K = K;
    pg8::StaticOrder S; S.init(M, N, (int)gridDim.x, (int)blockIdx.x);
    pg8::gemm_phase<Epi, pg8::StaticOrder, false>(lds, g, S, E, nullptr, wvi);
}

template <bool UPPERM = false> DI void conv_w(const float* __restrict__ src, bf16_t* __restrict__ dst, const float* __restrict__ nw, int K, int N, int Npad, ldsp lds, int wvi) {
    LAS float* tile = (LAS float*)lds;
    const int tid = otid(wvi);
    const int nkt = K / 64, ntile = nkt * (Npad / 128);
    for (int t = blockIdx.x; t < ntile; t += gridDim.x) {
        const int kt = t % nkt, nt = t / nkt, k0 = kt * 64, n0 = nt * 128;
        f32x4 v[4]; float sc[4];
#pragma unroll
        for (int i = 0; i < 4; ++i) {
            const int idx = tid + i * 512, r = idx >> 5, c4 = idx & 31, n = n0 + 4 * c4;
            v[i] = (f32x4){0.f, 0.f, 0.f, 0.f};
            if (n < N) v[i] = *(const f32x4*)(src + (size_t)(k0 + r) * N + n);
            sc[i] = nw ? nw[k0 + r] : 1.0f;
        }
#pragma unroll
        for (int i = 0; i < 4; ++i) {
            const int idx = tid + i * 512, r = idx >> 5, c4 = idx & 31;
            tile[r * 129 + 4 * c4 + 0] = v[i][0] * sc[i]; tile[r * 129 + 4 * c4 + 1] = v[i][1] * sc[i]; tile[r * 129 + 4 * c4 + 2] = v[i][2] * sc[i]; tile[r * 129 + 4 * c4 + 3] = v[i][3] * sc[i];
        }
        lds_barrier();
#pragma unroll
        for (int i = 0; i < 2; ++i) {
            const int idx = tid + i * 512, rn = idx >> 3, ck = idx & 7; u32x4 w;
            w.x = pack2(tile[(8 * ck + 0) * 129 + rn], tile[(8 * ck + 1) * 129 + rn]); w.y = pack2(tile[(8 * ck + 2) * 129 + rn], tile[(8 * ck + 3) * 129 + rn]);
            w.z = pack2(tile[(8 * ck + 4) * 129 + rn], tile[(8 * ck + 5) * 129 + rn]); w.w = pack2(tile[(8 * ck + 6) * 129 + rn], tile[(8 * ck + 7) * 129 + rn]);
            const int nn = n0 + rn;
            const int rr = UPPERM ? (nn < DFF ? 256 * (nn >> 7) + (nn & 127) : 256 * ((nn - DFF) >> 7) + 128 + ((nn - DFF) & 127)) : nn;
            *(u32x4*)(dst + (size_t)rr * K + k0 + 8 * ck) = w;
        }
        lds_barrier();
    }
}
DI void phase_setup(const Params& p, ldsp lds, int wvi) {
    unsigned char* ws = opq(p.ws);
    conv_w(p.in[6], (bf16_t*)(ws + OFF_WA_IN), p.in[2], 1024, 4112, 4224, lds, wvi);
    conv_w(p.in[11], (bf16_t*)(ws + OFF_WA_OUT), nullptr, 1024, 1024, 1024, lds, wvi);
    conv_w(p.in[12], (bf16_t*)(ws + OFF_WB_IN), p.in[2] + 1024, 1024, 1536, 1536, lds, wvi);
    conv_w(p.in[14], (bf16_t*)(ws + OFF_WB_OUT), nullptr, 1024, 1024, 1024, lds, wvi);
    conv_w<true>(p.in[15], (bf16_t*)(ws + OFF_WUP0), p.in[3], 1024, NUP, NUP, lds, wvi);
    conv_w<true>(p.in[15] + (size_t)1024 * NUP, (bf16_t*)(ws + OFF_WUP1), p.in[3] + 1024, 1024, NUP, NUP, lds, wvi);
    conv_w(p.in[17], (bf16_t*)(ws + OFF_WDN0), nullptr, DFF, 1024, 1024, lds, wvi);
    conv_w(p.in[17] + (size_t)DFF * 1024, (bf16_t*)(ws + OFF_WDN1), nullptr, DFF, 1024, 1024, lds, wvi);
    conv_w(p.in[19], (bf16_t*)(ws + OFF_WG0), p.in[4], 1024, 1024, 1024, lds, wvi);
    conv_w(p.in[19] + (size_t)1024 * 1024, (bf16_t*)(ws + OFF_WG1), p.in[4] + 1024, 1024, 1024, 1024, lds, wvi);
    conv_w(p.in[18], (bf16_t*)(ws + OFF_WP0), nullptr, 256, 1024, 1024, lds, wvi);
    conv_w(p.in[18] + (size_t)256 * 1024, (bf16_t*)(ws + OFF_WP1), nullptr, 256, 1024, 1024, lds, wvi);
    const int tid0 = otid(wvi); const int lane = tid0 & 63, wid = tid0 >> 6;
    const float* x = p.in[0]; bf16_t* hb = (bf16_t*)(ws + OFF_HB); float* ssA = (float*)(ws + OFF_SSA);
    const int rstep = gridDim.x * 8;
    f32x4 nx[4];
#pragma unroll
    for (int i = 0; i < 4; ++i) nx[i] = *(const f32x4*)(x + (size_t)(blockIdx.x * 8 + wid) * 1024 + i * 256 + lane * 4);
    for (int row = blockIdx.x * 8 + wid; row < MTOK; row += rstep) {
        f32x4 v[4];
#pragma unroll
        for (int i = 0; i < 4; ++i) v[i] = nx[i];
        if (row + rstep < MTOK) {
#pragma unroll
            for (int i = 0; i < 4; ++i) nx[i] = *(const f32x4*)(x + (size_t)(row + rstep) * 1024 + i * 256 + lane * 4); }
        float sq = 0.f;
#pragma unroll
        for (int i = 0; i < 4; ++i) {
            const size_t off = (size_t)row * 1024 + i * 256 + lane * 4;
            sq += (v[i][0] * v[i][0] + v[i][1] * v[i][1]) + (v[i][2] * v[i][2] + v[i][3] * v[i][3]);
            u32x2 w; w.x = pack2(v[i][0], v[i][1]); w.y = pack2(v[i][2], v[i][3]); *(u32x2*)(hb + off) = w;
        }
        sq = wave_sum(sq);
        if (lane == 0) { ssA[row] = sq; ((float*)(ws + OFF_SSB))[row] = 0.f; }
    }
}

DI void phase_ba(const Params& p, const float* ss, int wvi) {
    unsigned char* ws = opq(p.ws);
    const int tid = otid(wvi), wid = tid >> 6, lane = tid & 63, fr = lane & 15, fq = lane >> 4;
    const bf16_t* hb = (const bf16_t*)(ws + OFF_HB); const bf16_t* W = (const bf16_t*)(ws + OFF_WA_IN) + (size_t)(4096 + fr) * 1024 + 8 * fq;
    float* ba = (float*)(ws + OFF_BA);
    for (int rt = blockIdx.x * 8 + wid; rt < MTOK / 16; rt += gridDim.x * 8) {
        const bf16_t* ap = hb + (size_t)(16 * rt + fr) * 1024 + 8 * fq;
        f32x4 acc = {0.f, 0.f, 0.f, 0.f};
#pragma unroll 8
        for (int ks = 0; ks < 32; ++ks) acc = MFMA16(*(const bf16x8*)(ap + 32 * ks), *(const bf16x8*)(W + 32 * ks), acc);
#pragma unroll
        for (int j = 0; j < 4; ++j) { const int row = 16 * rt + 4 * fq + j; ba[(size_t)row * 16 + fr] = acc[j] * row_rstd(ss, row); }
    }
}
DI void phase_conv_a(const Params& p, int wvi) {
    unsigned char* ws = opq(p.ws);
    const int tid0 = otid(wvi); const int lane = tid0 & 63, wid = tid0 >> 6;
    const float* aconv = p.in[7];
    for (int ui = blockIdx.x * 8 + wid; ui < 4096 * 3; ui += gridDim.x * 8) {
        const int tz = ui % 3, ch = ui / 3, n = ch & 63, bh = ch >> 6, h = bh & 7, b = bh >> 3;
        const bf16_t* X = (const bf16_t*)(ws + OFF_XQ) + (size_t)tz * ((size_t)MTOK * 1024);
        bf16_t* Y = (bf16_t*)(ws + (tz == 0 ? OFF_HB : (tz == 1 ? OFF_YK : OFF_YV))) + (size_t)ch * 8192;
        const int col = h * 128 + 2 * lane;
        float w[4][2];
#pragma unroll
        for (int i = 0; i < 4; ++i) { w[i][0] = aconv[i * 3072 + tz * 1024 + col]; w[i][1] = aconv[i * 3072 + tz * 1024 + col + 1]; }
        const size_t tok0 = (size_t)b * SEQ + n * 64;
        const unsigned* Xr = (const unsigned*)(X + tok0 * 1024 + col);
        float x0[2] = {0.f, 0.f}, x1[2] = {0.f, 0.f}, x2[2] = {0.f, 0.f};
        if (n > 0) { const unsigned a = *(Xr - 3 * 512), bb = *(Xr - 2 * 512), c = *(Xr - 512);
            x0[0] = lo2f(a); x0[1] = hi2f(a); x1[0] = lo2f(bb); x1[1] = hi2f(bb); x2[0] = lo2f(c); x2[1] = hi2f(c); }
        const float qs = tz == 0 ? 0.08838834764831845f : 1.0f;
        unsigned nxt[16];
#pragma unroll
        for (int i = 0; i < 16; ++i) nxt[i] = Xr[(size_t)i * 512];
        for (int i0 = 0; i0 < 64; i0 += 16) {
            unsigned cur[16];
#pragma unroll
            for (int i = 0; i < 16; ++i) cur[i] = nxt[i];
            if (i0 + 16 < 64) {
#pragma unroll
                for (int i = 0; i < 16; ++i) nxt[i] = Xr[(size_t)(i0 + 16 + i) * 512]; }
            float y0[16], y1[16];
#pragma unroll
            for (int i = 0; i < 16; ++i) {
                const float c0 = lo2f(cur[i]), c1 = hi2f(cur[i]);
                float a0 = w[0][0] * x0[0] + w[1][0] * x1[0] + w[2][0] * x2[0] + w[3][0] * c0;
                float a1 = w[0][1] * x0[1] + w[1][1] * x1[1] + w[2][1] * x2[1] + w[3][1] * c1;
                y0[i] = siluf_(a0); y1[i] = siluf_(a1);
                x0[0] = x1[0]; x0[1] = x1[1]; x1[0] = x2[0]; x1[1] = x2[1]; x2[0] = c0; x2[1] = c1;
            }
            if (tz < 2) {
#pragma unroll
                for (int i = 0; i < 16; ++i) { const float sq = wave_sum(y0[i] * y0[i] + y1[i] * y1[i]); const float r = rsqrtf(sq + 1e-6f) * qs; y0[i] *= r; y1[i] *= r; }
            }
#pragma unroll
            for (int i = 0; i < 16; ++i) *(unsigned*)(Y + (size_t)(i0 + i) * 128 + 2 * lane) = pack2(y0[i], y1[i]);
        }
    }
}

DI int frag_off(int r, int k, int kblocks) { return ((r >> 4) * kblocks + (k >> 5)) * 512 + ((((k & 31) >> 3) * 16 + (r & 15)) << 3) + (k & 7); }
DI int u0_off(int dv, int i) { return ((dv >> 4) * 4 + (i >> 4)) * 256 + (((((i & 15) >> 2) * 16) + (dv & 15)) << 2) + (i & 3); }
constexpr int PREP_HALF = 3 * 17408 + 16384 + 1280;
DI void phase_prep(const Params& p, ldsp lds0, int wvi) {
    unsigned char* ws = opq(p.ws);
    const int tid = otid(wvi), half = tid >> 8, lt = tid & 255, lw = lt >> 6, lane = tid & 63, fr = lane & 15, fq = lane >> 4;
    ldsp lds = lds0 + half * PREP_HALF;
    LAS bf16_t* sQ = (LAS bf16_t*)lds; LAS bf16_t* sK = (LAS bf16_t*)(lds + 17408); LAS bf16_t* sV = (LAS bf16_t*)(lds + 2 * 17408);
    LAS float* sL = (LAS float*)(lds + 3 * 17408); LAS float* sG = (LAS float*)(lds + 3 * 17408 + 16384);
    LAS float* gcs = sG; LAS float* sbeta = sG + 64; LAS float* egcs = sG + 128; LAS float* ek = sG + 192; LAS float* bk = sG + 256;
    const float* ba = (const float*)(ws + OFF_BA);
    for (int u0 = blockIdx.x * 2; u0 < 4096; u0 += gridDim.x * 2) {
        const int ch = u0 + half, n = ch & 63, bh = ch >> 6, h = bh & 7, b = bh >> 3;
        bf16_t* Yq = (bf16_t*)(ws + OFF_HB) + (size_t)ch * 8192; bf16_t* Yk = (bf16_t*)(ws + OFF_YK) + (size_t)ch * 8192; bf16_t* Yv = (bf16_t*)(ws + OFF_YV) + (size_t)ch * 8192;
        bf16_t* WK = (bf16_t*)(ws + OFF_XK) + (size_t)ch * 8192; bf16_t* QK = (bf16_t*)(ws + OFF_XV) + (size_t)ch * 4096;
        { u32x4 vq[4], vk[4], vv[4];
#pragma unroll
          for (int ps = 0; ps < 4; ++ps) { const int idx = lt + ps * 256, row = idx >> 4, c8 = idx & 15;
              vq[ps] = *(const u32x4*)(Yq + row * 128 + 8 * c8); vk[ps] = *(const u32x4*)(Yk + row * 128 + 8 * c8); vv[ps] = *(const u32x4*)(Yv + row * 128 + 8 * c8); }
          asm volatile("" ::: "memory");
#pragma unroll
          for (int ps = 0; ps < 4; ++ps) { const int idx = lt + ps * 256, row = idx >> 4, c8 = idx & 15;
              *(LAS u32x4*)(sQ + row * 136 + 8 * c8) = vq[ps]; *(LAS u32x4*)(sK + row * 136 + 8 * c8) = vk[ps]; *(LAS u32x4*)(sV + row * 136 + 8 * c8) = vv[ps]; } }
        if (lw == 0) {
            const size_t tok = (size_t)b * SEQ + n * 64 + lane;
            const float bl = ba[tok * 16 + h], ain = ba[tok * 16 + 8 + h];
            const float beta = sigmoidf_(bl);
            const float xsp = ain + p.in[9][h];
            const float ey = __expf(xsp);
            const float sp = xsp > 20.f ? xsp : (ey < 0.01f ? ey * (1.0f - ey * (0.5f - ey * 0.33333333f)) : __logf(1.0f + ey));
            float g = -__expf(p.in[8][h]) * sp;
#pragma unroll
            for (int o = 1; o < 64; o <<= 1) { const float t = __shfl_up(g, o); if (lane >= o) g += t; }
            const float glast = __shfl(g, 63);
            const float eg = __expf(g);
            gcs[lane] = g; sbeta[lane] = beta; egcs[lane] = eg; ek[lane] = __expf(glast - g); bk[lane] = beta * eg;
        }
        lds_barrier();
        {
            const int mi = lw;
            bf16x8 ak[4], aq[4];
#pragma unroll
            for (int ks = 0; ks < 4; ++ks) { ak[ks] = *(const LAS bf16x8*)(sK + (16 * mi + fr) * 136 + 32 * ks + 8 * fq); aq[ks] = *(const LAS bf16x8*)(sQ + (16 * mi + fr) * 136 + 32 * ks + 8 * fq); }
#pragma unroll
            for (int nj = 0; nj < 4; ++nj) {
                f32x4 akk = {0.f, 0.f, 0.f, 0.f}, aqk = {0.f, 0.f, 0.f, 0.f};
                if (nj <= mi) {
#pragma unroll
                    for (int ks = 0; ks < 4; ++ks) { const bf16x8 bkf = *(const LAS bf16x8*)(sK + (16 * nj + fr) * 136 + 32 * ks + 8 * fq); akk = MFMA16(ak[ks], bkf, akk); aqk = MFMA16(aq[ks], bkf, aqk); }
                }
                const int jj = 16 * nj + fr; const float gj = gcs[jj];
#pragma unroll
                for (int j = 0; j < 4; ++j) {
                    const int i = 16 * mi + 4 * fq + j; const float gi = gcs[i];
                    const float dec = jj <= i ? __expf(gi - gj) : 0.f;
                    sL[i * 64 + jj] = jj < i ? sbeta[i] * akk[j] * dec : 0.f;
                    QK[frag_off(i, jj, 2)] = f2bf(jj <= i ? aqk[j] * dec : 0.f);
                }
            }
        }
        lds_barrier();
        {
            const bool isv = lt < 128; const int cc = lt & 127;
            LAS bf16_t* srcT = isv ? sV : sK; LAS float* scl = isv ? sbeta : bk;
            float x[64];
#pragma unroll
            for (int ib = 0; ib < 16; ++ib) {
                const int i = 4 * ib;
                f32x4 s[4];
#pragma unroll
                for (int r = 0; r < 4; ++r) s[r] = (f32x4){0.f, 0.f, 0.f, 0.f};
#pragma unroll
                for (int j4 = 0; j4 < ib; ++j4) {
#pragma unroll
                    for (int r = 0; r < 4; ++r) { const f32x4 l = *(const LAS f32x4*)(sL + (i + r) * 64 + 4 * j4);
                        s[r][0] += l[0] * x[4 * j4]; s[r][1] += l[1] * x[4 * j4 + 1]; s[r][2] += l[2] * x[4 * j4 + 2]; s[r][3] += l[3] * x[4 * j4 + 3]; }
                    if ((j4 & 1) == 1) asm volatile("" ::: "memory");
                }
                f32x4 d[4]; float rh[4];
#pragma unroll
                for (int r = 0; r < 4; ++r) { d[r] = *(const LAS f32x4*)(sL + (i + r) * 64 + i); rh[r] = bf2f(srcT[(i + r) * 136 + cc]) * scl[i + r] - ((s[r][0] + s[r][1]) + (s[r][2] + s[r][3])); }
                x[i] = rh[0];
                x[i + 1] = rh[1] - d[1][0] * x[i];
                x[i + 2] = rh[2] - d[2][0] * x[i] - d[2][1] * x[i + 1];
                x[i + 3] = rh[3] - d[3][0] * x[i] - d[3][1] * x[i + 1] - d[3][2] * x[i + 2];
                asm volatile("" ::: "memory");
            }
            if (isv) {
#pragma unroll
                for (int g4 = 0; g4 < 16; ++g4) { u32x2 w; w.x = pack2(x[4 * g4], x[4 * g4 + 1]); w.y = pack2(x[4 * g4 + 2], x[4 * g4 + 3]);
                    *(u32x2*)(Yv + u0_off(cc, 4 * g4)) = w; }
            }
            lds_barrier();
            if (!isv) {
#pragma unroll
                for (int i = 0; i < 64; ++i) sV[i * 136 + cc] = f2bf(x[i]);
            }
        }
        lds_barrier();
#pragma unroll
        for (int ps = 0; ps < 4; ++ps) { const int idx = lt + ps * 256, row = idx >> 4, c8 = idx & 15; *(u32x4*)(WK + frag_off(row, 8 * c8, 4)) = *(const LAS u32x4*)(sV + row * 136 + 8 * c8); }
#pragma unroll
        for (int ps = 0; ps < 4; ++ps) {
            const int idx = lt + ps * 256;
            { const int row = idx >> 4, c8 = idx & 15; const float e = egcs[row]; const u32x4 v = *(const LAS u32x4*)(sQ + row * 136 + 8 * c8); u32x4 w;
              w.x = pack2(lo2f(v.x) * e, hi2f(v.x) * e); w.y = pack2(lo2f(v.y) * e, hi2f(v.y) * e); w.z = pack2(lo2f(v.z) * e, hi2f(v.z) * e); w.w = pack2(lo2f(v.w) * e, hi2f(v.w) * e);
              *(u32x4*)(Yq + frag_off(row, 8 * c8, 4)) = w; }
            { const int d = idx >> 3, i8 = idx & 7; float v[8];
#pragma unroll
              for (int e = 0; e < 8; ++e) v[e] = bf2f(sK[(8 * i8 + e) * 136 + d]) * ek[8 * i8 + e];
              u32x4 w; w.x = pack2(v[0], v[1]); w.y = pack2(v[2], v[3]); w.z = pack2(v[4], v[5]); w.w = pack2(v[6], v[7]);
              *(u32x4*)(Yk + frag_off(d, 8 * i8, 2)) = w; }
        }
        if (lt == 0) ((float*)(ws + OFF_GL))[ch] = egcs[63];
        lds_barrier();
    }
}

DI void phase_scan(const Params& p, ldsp lds, int wvi) {
    unsigned char* ws = opq(p.ws);
    const int tid = otid(wvi), wid = tid >> 6, lane = tid & 63, fr = lane & 15, fq = lane >> 4, kind = wid >> 2, mi = wid & 3;
    LAS bf16_t* sST = (LAS bf16_t*)lds;
    LAS bf16_t* sUT = (LAS bf16_t*)(lds + 32 * 272);
    for (int un = blockIdx.x; un < 256; un += gridDim.x) {
        const int sl = (un >> 3) & 3, bh = (un & 7) * 8 + (un >> 5), h = bh & 7, b = bh >> 3;
        const bf16_t* pA = (const bf16_t*)(ws + (kind ? OFF_HB : OFF_XK)) + (size_t)bh * 64 * 8192 + mi * 4 * 512 + lane * 8;
        const bf16_t* pK = (const bf16_t*)(ws + OFF_YK) + (size_t)bh * 64 * 8192 + wid * 2 * 512 + lane * 8;
        const bf16_t* pQK = (const bf16_t*)(ws + OFF_XV) + (size_t)bh * 64 * 4096 + mi * 2 * 512 + lane * 8;
        const bf16_t* pU0 = (const bf16_t*)(ws + OFF_YV) + (size_t)bh * 64 * 8192 + ((sl * 2) * 4 + mi) * 256 + lane * 4;
        const float* GL = (const float*)(ws + OFF_GL) + bh * 64;
        bf16_t* O = (bf16_t*)(ws + OFF_XQ) + ((size_t)b * SEQ + 16 * mi + 4 * fq) * 1024 + h * 128 + sl * 32 + fr;
        for (int i = tid; i < 32 * 136 / 2; i += 512) ((LAS unsigned*)sST)[i] = 0u;
        f32x4 Sacc[2] = {{0.f, 0.f, 0.f, 0.f}, {0.f, 0.f, 0.f, 0.f}};
        bf16x8 fA[4][4]; u32x4 fB[4][2]; u32x2 fU[4][2]; bf16x8 fK[4][2]; float fg[4];
#define SCAN_LOAD(s, nn) do { \
            _Pragma("unroll") for (int ks = 0; ks < 4; ++ks) fA[s][ks] = *(const bf16x8*)(pA + (size_t)(nn) * 8192 + 512 * ks); \
            _Pragma("unroll") for (int ks = 0; ks < 2; ++ks) fK[s][ks] = *(const bf16x8*)(pK + (size_t)(nn) * 8192 + 512 * ks); \
            if (kind) { fB[s][0] = *(const u32x4*)(pQK + (size_t)(nn) * 4096); fB[s][1] = *(const u32x4*)(pQK + (size_t)(nn) * 4096 + 512); } \
            else { fU[s][0] = *(const u32x2*)(pU0 + (size_t)(nn) * 8192); fU[s][1] = *(const u32x2*)(pU0 + (size_t)(nn) * 8192 + 4 * 256); } \
            fg[s] = GL[nn]; } while (0)
        SCAN_LOAD(0, 0); SCAN_LOAD(1, 1); SCAN_LOAD(2, 2);
        lds_barrier();
        for (int n0 = 0; n0 < 64; n0 += 4) {
#pragma unroll
            for (int s = 0; s < 4; ++s) {
                const int n = n0 + s;
                SCAN_LOAD((s + 3) & 3, (n + 3 < 64 ? n + 3 : 63));
                f32x4 a0 = {0.f, 0.f, 0.f, 0.f}, a1 = {0.f, 0.f, 0.f, 0.f};
#pragma unroll
                for (int ks = 0; ks < 4; ++ks) {
                    const bf16x8 st0 = *(const LAS bf16x8*)(sST + fr * 136 + 32 * ks + 8 * fq), st1 = *(const LAS bf16x8*)(sST + (16 + fr) * 136 + 32 * ks + 8 * fq);
                    a0 = MFMA16(fA[s][ks], st0, a0); a1 = MFMA16(fA[s][ks], st1, a1);
                }
                if (!kind) {
                    const u32x2 ua = fU[s][0], ub = fU[s][1];
                    u32x2 w0, w1;
                    w0.x = pack2(lo2f(ua.x) - a0[0], hi2f(ua.x) - a0[1]); w0.y = pack2(lo2f(ua.y) - a0[2], hi2f(ua.y) - a0[3]);
                    w1.x = pack2(lo2f(ub.x) - a1[0], hi2f(ub.x) - a1[1]); w1.y = pack2(lo2f(ub.y) - a1[2], hi2f(ub.y) - a1[3]);
                    *(LAS u32x2*)(sUT + fr * 72 + 16 * mi + 4 * fq) = w0; *(LAS u32x2*)(sUT + (16 + fr) * 72 + 16 * mi + 4 * fq) = w1;
                }
                lds_barrier();
                bf16x8 ut0[2], ut1[2];
#pragma unroll
                for (int ks = 0; ks < 2; ++ks) { ut0[ks] = *(const LAS bf16x8*)(sUT + fr * 72 + 32 * ks + 8 * fq); ut1[ks] = *(const LAS bf16x8*)(sUT + (16 + fr) * 72 + 32 * ks + 8 * fq); }
                if (kind) {
#pragma unroll
                    for (int ks = 0; ks < 2; ++ks) { const bf16x8 qk = __builtin_bit_cast(bf16x8, fB[s][ks]); a0 = MFMA16(qk, ut0[ks], a0); a1 = MFMA16(qk, ut1[ks], a1); }
                    bf16_t* op = O + (size_t)n * 64 * 1024;
#pragma unroll
                    for (int j = 0; j < 4; ++j) { op[(size_t)j * 1024] = f2bf(a0[j]); op[(size_t)j * 1024 + 16] = f2bf(a1[j]); }
                }
                const float cgl = fg[s];
                Sacc[0] *= cgl; Sacc[1] *= cgl;
#pragma unroll
                for (int ks = 0; ks < 2; ++ks) { Sacc[0] = MFMA16(fK[s][ks], ut0[ks], Sacc[0]); Sacc[1] = MFMA16(fK[s][ks], ut1[ks], Sacc[1]); }
#pragma unroll
                for (int nv = 0; nv < 2; ++nv) { u32x2 w; w.x = pack2(Sacc[nv][0], Sacc[nv][1]); w.y = pack2(Sacc[nv][2], Sacc[nv][3]); *(LAS u32x2*)(sST + (16 * nv + fr) * 136 + 16 * wid + 4 * fq) = w; }
                lds_barrier();
            }
        }
#undef SCAN_LOAD
    }
}

DI void phase_gate(const Params& p, int wvi) {
    unsigned char* ws = opq(p.ws);
    const int tid0 = otid(wvi); const int lane = tid0 & 63, wid = tid0 >> 6;
    bf16_t* O = (bf16_t*)(ws + OFF_XQ); const bf16_t* Z = (const bf16_t*)(ws + OFF_XZ);
    const float* nw = p.in[10];
    float wv[16];
#pragma unroll
    for (int e = 0; e < 16; ++e) wv[e] = nw[(lane & 7) * 16 + e];
    const int rstep = gridDim.x * 8;
    u32x4 no0, no1, nz0, nz1;
    { const size_t off = (size_t)(blockIdx.x * 8 + wid) * 1024 + lane * 16; no0 = *(const u32x4*)(O + off); no1 = *(const u32x4*)(O + off + 8); nz0 = *(const u32x4*)(Z + off); nz1 = *(const u32x4*)(Z + off + 8); }
    for (int row = blockIdx.x * 8 + wid; row < MTOK; row += rstep) {
        const size_t off = (size_t)row * 1024 + lane * 16;
        const u32x4 o0 = no0, o1 = no1, z0 = nz0, z1 = nz1;
        if (row + rstep < MTOK) { const size_t o2 = off + (size_t)rstep * 1024; no0 = *(const u32x4*)(O + o2); no1 = *(const u32x4*)(O + o2 + 8); nz0 = *(const u32x4*)(Z + o2); nz1 = *(const u32x4*)(Z + o2 + 8); }
        float ov[16], zv[16];
        ov[0] = lo2f(o0.x); ov[1] = hi2f(o0.x); ov[2] = lo2f(o0.y); ov[3] = hi2f(o0.y); ov[4] = lo2f(o0.z); ov[5] = hi2f(o0.z); ov[6] = lo2f(o0.w); ov[7] = hi2f(o0.w);
        ov[8] = lo2f(o1.x); ov[9] = hi2f(o1.x); ov[10] = lo2f(o1.y); ov[11] = hi2f(o1.y); ov[12] = lo2f(o1.z); ov[13] = hi2f(o1.z); ov[14] = lo2f(o1.w); ov[15] = hi2f(o1.w);
        zv[0] = lo2f(z0.x); zv[1] = hi2f(z0.x); zv[2] = lo2f(z0.y); zv[3] = hi2f(z0.y); zv[4] = lo2f(z0.z); zv[5] = hi2f(z0.z); zv[6] = lo2f(z0.w); zv[7] = hi2f(z0.w);
        zv[8] = lo2f(z1.x); zv[9] = hi2f(z1.x); zv[10] = lo2f(z1.y); zv[11] = hi2f(z1.y); zv[12] = lo2f(z1.z); zv[13] = hi2f(z1.z); zv[14] = lo2f(z1.w); zv[15] = hi2f(z1.w);
        float sq = 0.f;
#pragma unroll
        for (int e = 0; e < 16; ++e) sq += ov[e] * ov[e];
        sq += __shfl_xor(sq, 1); sq += __shfl_xor(sq, 2); sq += __shfl_xor(sq, 4);
        const float rs = rsqrtf(sq * (1.0f / 128.0f) + 1e-6f);
        float r[16];
#pragma unroll
        for (int e = 0; e < 16; ++e) r[e] = ov[e] * rs * wv[e] * siluf_(zv[e]);
        u32x4 w0, w1;
        w0.x = pack2(r[0], r[1]); w0.y = pack2(r[2], r[3]); w0.z = pack2(r[4], r[5]); w0.w = pack2(r[6], r[7]);
        w1.x = pack2(r[8], r[9]); w1.y = pack2(r[10], r[11]); w1.z = pack2(r[12], r[13]); w1.w = pack2(r[14], r[15]);
        *(u32x4*)(O + off) = w0; *(u32x4*)(O + off + 8) = w1;
    }
}

DI void zero_ss(float* s, int wvi) { for (int i = blockIdx.x * 512 + otid(wvi); i < MTOK; i += gridDim.x * 512) s[i] = 0.f; }
DI void phase_convert_p(const Params& p, int layer, int wvi) {
    unsigned char* ws = opq(p.ws);
    const int gt = blockIdx.x * 512 + otid(wvi), nth = gridDim.x * 512;
    const float* ps = p.in[1] + (size_t)layer * MTOK * 256; bf16_t* pb = (bf16_t*)(ws + OFF_PB);
    for (size_t i = (size_t)gt * 8; i < (size_t)MTOK * 256; i += (size_t)nth * 8) {
        const f32x4 a = *(const f32x4*)(ps + i), b = *(const f32x4*)(ps + i + 4);
        u32x4 w; w.x = pack2(a[0], a[1]); w.y = pack2(a[2], a[3]); w.z = pack2(b[0], b[1]); w.w = pack2(b[2], b[3]);
        *(u32x4*)(pb + i) = w;
    }
}
DI void phase_attn(const Params& p, ldsp lds, int wvi) {
    unsigned char* ws = opq(p.ws);
    const int tid = otid(wvi), wid = tid >> 6, lane = tid & 63, fr = lane & 15, fq = lane >> 4, gi = wid >> 1, qh = wid & 1;
    LAS bf16_t* sK = (LAS bf16_t*)lds; LAS bf16_t* sVT = (LAS bf16_t*)(lds + 36864); LAS bf16_t* sP = (LAS bf16_t*)(lds + 36864 + 33792 + wid * 8448);
    const bf16_t* Q = (const bf16_t*)(ws + OFF_BQ); const bf16_t* Kg = (const bf16_t*)(ws + OFF_BK); const bf16_t* Vg = (const bf16_t*)(ws + OFF_BV);
    bf16_t* AO = (bf16_t*)(ws + OFF_AO);
    u32x4 pk[4], pv[4];
#define ATT_FETCH(unx) do { const int g_ = (unx) & 3, nb_ = ((unx) >> 2) & 31, b_ = (unx) >> 7; \
        _Pragma("unroll") for (int ps = 0; ps < 4; ++ps) { const int idx = tid + ps * 512, kj = idx >> 3, c8 = idx & 7; const int tk = (nb_ - 1) * 128 + kj; \
            pk[ps] = (u32x4){0u, 0u, 0u, 0u}; pv[ps] = (u32x4){0u, 0u, 0u, 0u}; \
            if (tk >= 0) { const size_t off = ((size_t)b_ * SEQ + tk) * 256 + g_ * 64 + 8 * c8; pk[ps] = *(const u32x4*)(Kg + off); pv[ps] = *(const u32x4*)(Vg + off); } } } while (0)
    if ((int)blockIdx.x < 1024) ATT_FETCH((int)blockIdx.x);
    for (int un = blockIdx.x; un < 1024; un += gridDim.x) {
        const int g = un & 3, nb = (un >> 2) & 31, b = un >> 7;
        const int hq = g * 4 + gi;
        const float slope = exp2f(-0.5f * (float)(hq + 1)), sink = p.in[13][hq];
        const bf16_t* qbase = Q + ((size_t)b * SEQ + nb * 128 + 64 * qh + fr) * 1024 + hq * 64 + 8 * fq;
        bf16x8 nq0 = *(const bf16x8*)qbase, nq1 = *(const bf16x8*)(qbase + 32);
        lds_barrier();
#pragma unroll
        for (int ps = 0; ps < 4; ++ps) {
            const int idx = tid + ps * 512, kj = idx >> 3, c8 = idx & 7;
            *(LAS u32x4*)(sK + kj * 72 + 8 * c8) = pk[ps];
            const unsigned vw[4] = {pv[ps].x, pv[ps].y, pv[ps].z, pv[ps].w};
            const int pcol = ((((kj >> 3) ^ c8) << 3) | (kj & 7));
#pragma unroll
            for (int e = 0; e < 4; ++e) { sVT[(8 * c8 + 2 * e) * 264 + pcol] = (bf16_t)(vw[e] & 0xffffu); sVT[(8 * c8 + 2 * e + 1) * 264 + pcol] = (bf16_t)(vw[e] >> 16); }
        }
        lds_barrier();
        if (un + (int)gridDim.x < 1024) ATT_FETCH(un + (int)gridDim.x);
        for (int mt = 0; mt < 4; ++mt) {
            const int q0 = 64 * qh + 16 * mt;
            const bf16x8 qf0 = nq0, qf1 = nq1;
            if (mt < 3) { nq0 = *(const bf16x8*)(qbase + (size_t)(mt + 1) * 16 * 1024); nq1 = *(const bf16x8*)(qbase + (size_t)(mt + 1) * 16 * 1024 + 32); }
            const int nt0 = 4 * qh + mt;
            f32x4 sc[9];
#pragma unroll
            for (int i = 0; i < 9; ++i) { const int nt = nt0 + i;
                f32x4 a = {0.f, 0.f, 0.f, 0.f};
                const bf16x8 k0 = *(const LAS bf16x8*)(sK + (16 * nt + fr) * 72 + 8 * fq), k1 = *(const LAS bf16x8*)(sK + (16 * nt + fr) * 72 + 32 + 8 * fq);
                a = MFMA16(k0, qf0, a); a = MFMA16(k1, qf1, a); sc[i] = a;
            }
            const int qi = q0 + fr;
            float mx = -1e30f;
#pragma unroll
            for (int i = 0; i < 9; ++i) {
#pragma unroll
                for (int j = 0; j < 4; ++j) {
                    const int kj = 16 * (nt0 + i) + 4 * fq + j, dist = qi + 128 - kj;
                    const bool valid = dist >= 0 && dist < 128 && (nb > 0 || kj >= 128);
                    const float lg = valid ? sc[i][j] * 0.125f - slope * (float)dist : -1e30f;
                    sc[i][j] = lg; mx = fmaxf(mx, lg);
                }
            }
            mx = fmaxf(mx, __shfl_xor(mx, 16)); mx = fmaxf(mx, __shfl_xor(mx, 32)); mx = fmaxf(mx, sink);
            float sm = 0.f;
#pragma unroll
            for (int i = 0; i < 9; ++i)
#pragma unroll
                for (int j = 0; j < 4; ++j) { const float e = sc[i][j] > -1e29f ? __expf(sc[i][j] - mx) : 0.f; sc[i][j] = e; sm += e; }
            sm += __shfl_xor(sm, 16); sm += __shfl_xor(sm, 32);
            sm = 1.0f / (sm + __expf(sink - mx));
#pragma unroll
            for (int i = 0; i < 9; ++i) { u32x2 w; w.x = pack2(sc[i][0] * sm, sc[i][1] * sm); w.y = pack2(sc[i][2] * sm, sc[i][3] * sm); *(LAS u32x2*)(sP + fr * 264 + 16 * (nt0 + i) + 4 * fq) = w; }
            { const int xt = (nt0 & 1) ? nt0 - 1 : nt0 + 9;
              *(LAS u32x2*)(sP + fr * 264 + 16 * xt + 4 * fq) = (u32x2){0u, 0u}; }
            asm volatile("s_waitcnt lgkmcnt(0)" ::: "memory");
            f32x4 oa[4] = {{0.f, 0.f, 0.f, 0.f}, {0.f, 0.f, 0.f, 0.f}, {0.f, 0.f, 0.f, 0.f}, {0.f, 0.f, 0.f, 0.f}};
#pragma unroll
            for (int ksi = 0; ksi < 5; ++ksi) { const int ks = (nt0 >> 1) + ksi;
                const bf16x8 pf = *(const LAS bf16x8*)(sP + fr * 264 + 32 * ks + 8 * fq);
#pragma unroll
                for (int nd = 0; nd < 4; ++nd) { const bf16x8 vf = *(const LAS bf16x8*)(sVT + (16 * nd + fr) * 264 + ((((4 * ks + fq) ^ ((2 * nd + (fr >> 3)) & 7))) << 3)); oa[nd] = MFMA16(pf, vf, oa[nd]); }
            }
            asm volatile("s_waitcnt lgkmcnt(0)" ::: "memory");
            bf16_t* op = AO + ((size_t)b * SEQ + nb * 128 + q0 + 4 * fq) * 1024 + hq * 64 + fr;
#pragma unroll
            for (int nd = 0; nd < 4; ++nd)
#pragma unroll
                for (int j = 0; j < 4; ++j) op[(size_t)j * 1024 + 16 * nd] = f2bf(oa[nd][j]);
        }
    }
#undef ATT_FETCH
}

DI void phase_final(const Params& p, const float* ss, int wvi) {
    const int tid0 = otid(wvi); const int lane = tid0 & 63, wid = tid0 >> 6;
    const float* nw = p.in[5]; float* h = p.out;
    f32x4 wv[4];
#pragma unroll
    for (int i = 0; i < 4; ++i) wv[i] = *(const f32x4*)(nw + i * 256 + lane * 4);
    const int rstep = gridDim.x * 8;
    f32x4 nv[4]; float nss;
    { const int r0 = blockIdx.x * 8 + wid; nss = ss[r0];
#pragma unroll
      for (int i = 0; i < 4; ++i) nv[i] = *(const f32x4*)(h + (size_t)r0 * 1024 + i * 256 + lane * 4); }
    for (int row = blockIdx.x * 8 + wid; row < MTOK; row += rstep) {
        f32x4 v[4]; const float css = nss;
#pragma unroll
        for (int i = 0; i < 4; ++i) v[i] = nv[i];
        if (row + rstep < MTOK) { nss = ss[row + rstep];
#pragma unroll
            for (int i = 0; i < 4; ++i) nv[i] = *(const f32x4*)(h + (size_t)(row + rstep) * 1024 + i * 256 + lane * 4); }
        const float rs = rsqrtf(css * (1.0f / 1024.0f) + 1e-6f);
#pragma unroll
        for (int i = 0; i < 4; ++i) *(f32x4*)(h + (size_t)row * 1024 + i * 256 + lane * 4) = v[i] * rs * wv[i];
    }
}

__global__ void __launch_bounds__(512, 2) hybrid_fwd(Params p) {
    extern __shared__ __attribute__((aligned(16))) unsigned char shm[];
    ldsp lds = (ldsp)shm;
    cg::grid_group grid = cg::this_grid();
    const int wvi = __builtin_amdgcn_readfirstlane((int)(threadIdx.x >> 6));
    volatile LAS unsigned* st = (volatile LAS unsigned*)(lds + LDS_ST_OFF);
    if (threadIdx.x == 0) { st[0] = 0u; st[1] = 0u; }
    __syncthreads();
    const XcdBarrier xb = xcd_barrier_post((unsigned*)(p.ws + OFF_BAR), st);
    phase_setup(p, lds, wvi);
    grid.sync();
#pragma nounroll
    for (int layer = 0; layer < 2; ++layer) {
        unsigned char* ws = opq(p.ws);
        float* ssA = (float*)(ws + OFF_SSA); float* ssB = (float*)(ws + OFF_SSB);
        float* s0 = layer ? ssB : ssA; float* s1 = layer ? ssA : ssB;
        if (layer) zero_ss(s1, wvi);
        if (layer == 0) {
            phase_ba(p, s0, wvi);
            { EpiProjA E; E.X = (bf16_t*)(ws + OFF_XQ); E.ba = (float*)(ws + OFF_BA); E.ss = s0;
              run_gemm(lds, wvi, (const bf16_t*)(ws + OFF_HB), (const bf16_t*)(ws + OFF_WA_IN), MTOK, 4096, 1024, E); }
            xcd_barrier(xb);
            phase_conv_a(p, wvi);
            xcd_barrier(xb);
            phase_prep(p, lds, wvi);
            xcd_barrier(xb);
            phase_scan(p, lds, wvi);
            xcd_barrier(xb);
            phase_gate(p, wvi);
            xcd_barrier(xb);
        } else {
            { EpiProjB E; E.Q = (bf16_t*)(ws + OFF_BQ); E.K = (bf16_t*)(ws + OFF_BK); E.V = (bf16_t*)(ws + OFF_BV); E.ss = s0;
              run_gemm(lds, wvi, (const bf16_t*)(ws + OFF_HB2), (const bf16_t*)(ws + OFF_WB_IN), MTOK, 1536, 1024, E); }
            xcd_barrier(xb);
            phase_attn(p, lds, wvi);
            xcd_barrier(xb);
        }
        { EpiResidual E; E.hsrc = layer ? p.out : p.in[0]; E.hdst = p.out; E.hb = (bf16_t*)(ws + OFF_HB); E.ssout = s1; E.rowbase = 0;
          run_gemm(lds, wvi, (const bf16_t*)(ws + (layer ? OFF_AO : OFF_XQ)), (const bf16_t*)(ws + (layer ? OFF_WB_OUT : OFF_WA_OUT)), MTOK, 1024, 1024, E); }
        xcd_barrier(xb);
        const bf16_t* wup = (const bf16_t*)(ws + (layer ? OFF_WUP1 : OFF_WUP0)); const bf16_t* wdn = (const bf16_t*)(ws + (layer ? OFF_WDN1 : OFF_WDN0));
        phase_convert_p(p, layer, wvi);
        zero_ss(s0, wvi);
        { EpiUpAct E; E.ACT = (bf16_t*)(ws + OFF_ACT); E.ss = s1; E.cw = p.in[16] + (size_t)layer * 3 * NUP; E.RAW = (float*)(ws + OFF_RAW);
          run_gemm_amap(lds, wvi, (const bf16_t*)(ws + OFF_HB), wup, 128, NUP, 1024, E); }
        xcd_barrier(xb);
        zero_ss(s1, wvi);
        { pg8::StaticOrder S; S.init(MTOK, 1024, (int)gridDim.x, (int)blockIdx.x); pg8::Unit uu;
          for (int i = 0; S.next(i, uu); ++i) ffn_fixup_panel(p, layer, uu.pm, s1, wvi);
          asm volatile("s_waitcnt vmcnt(0)" ::: "memory"); __syncthreads(); }
        { EpiResidual E; E.hsrc = p.out; E.hdst = p.out; E.hb = (bf16_t*)(ws + OFF_HB); E.ssout = s0; E.rowbase = 0;
          run_gemm(lds, wvi, (const bf16_t*)(ws + OFF_ACT), wdn, MTOK, 1024, DFF, E); }
        xcd_barrier(xb);
        { EpiPlain E; E.O = (bf16_t*)(ws + OFF_PP);
          run_gemm(lds, wvi, (const bf16_t*)(ws + OFF_PB), (const bf16_t*)(ws + (layer ? OFF_WP1 : OFF_WP0)), MTOK, 1024, 256, E); }
        { EpiPle E; E.h = p.out; E.hb = (bf16_t*)(ws + OFF_HB2); E.pp = (const bf16_t*)(ws + OFF_PP); E.ssin = s0; E.ssout = s1;
          run_gemm(lds, wvi, (const bf16_t*)(ws + OFF_HB), (const bf16_t*)(ws + (layer ? OFF_WG1 : OFF_WG0)), MTOK, 1024, 1024, E); }
        xcd_barrier(xb);
    }
    phase_final(p, (const float*)(opq(p.ws) + OFF_SSA), wvi);
}

extern "C" void kernel_launch(void* const* d_in, const int* in_sizes, int n_in, void* d_out, int out_size, void* d_ws, size_t ws_size, hipStream_t stream) {
    static int grid_blocks = 0;
    if (grid_blocks == 0) {
        if (n_in != 20 || out_size != MTOK * DM || ws_size < WS_NEED) { fprintf(stderr, "kernel_launch: unexpected shapes (n_in %d, out %d, ws %zu, need %zu)\n", n_in, out_size, ws_size, (size_t)WS_NEED); grid_blocks = -1; return; }
        int dev = 0, cus = 0, per_cu = 0;
        (void)hipGetDevice(&dev);
        (void)hipDeviceGetAttribute(&cus, hipDeviceAttributeMultiprocessorCount, dev);
        if (hipFuncSetAttribute((const void*)hybrid_fwd, hipFuncAttributeMaxDynamicSharedMemorySize, LDS_BYTES) != hipSuccess) { fprintf(stderr, "kernel_launch: hipFuncSetAttribute failed\n"); grid_blocks = -1; return; }
        if (hipOccupancyMaxActiveBlocksPerMultiprocessor(&per_cu, (const void*)hybrid_fwd, 512, LDS_BYTES) != hipSuccess || per_cu < 1) { fprintf(stderr, "kernel_launch: occupancy query failed (%d)\n", per_cu); (void)hipGetLastError(); per_cu = 1; }
        if (per_cu > 1) per_cu = 1;
        grid_blocks = cus * per_cu;
    }
    if (grid_blocks < 0) return;
    Params p{};
    for (int i = 0; i < 20; ++i) p.in[i] = (const float*)d_in[i];
    p.out = (float*)d_out; p.ws = (unsigned char*)d_ws;
    if (hipMemsetAsync((char*)d_ws + OFF_BAR, 0, XCD_BAR_WORDS * sizeof(unsigned), stream) != hipSuccess) { fprintf(stderr, "kernel_launch: memset failed\n"); return; }
    void* args[] = {&p};
    hipError_t e = hipLaunchCooperativeKernel((const void*)hybrid_fwd, dim3(grid_blocks), dim3(512), args, LDS_BYTES, stream);
    if (e != hipSuccess) fprintf(stderr, "cooperative launch failed: %s (grid %d)\n", hipGetErrorString(e), grid_blocks);
}
```

```cpp
#include <hip/hip_runtime.h>
#include <hip/hip_cooperative_groups.h>
#include <cstdio>
namespace cg = cooperative_groups;
namespace pg8 {
#define PG8_LAS __attribute__((address_space(3)))
typedef unsigned short bf16_t;
typedef short bf16x8 __attribute__((ext_vector_type(8)));
typedef float f32x4 __attribute__((ext_vector_type(4)));
typedef unsigned u32x4 __attribute__((ext_vector_type(4)));
constexpr int BM = 256, BK = 64, HALF = 128, HTB = HALF * BK * 2  , STAGE_BYTES = 8 * HTB, NXCD = 8, WGM = 8;

__host__ __device__ __forceinline__ int lds_byte(int r, int c) { const int st = (r >> 4) * 2 + (c >> 5), rr = r & 15, cc = c & 31, ob = rr * 64 + cc * 2; return st * 1024 + (ob ^ (((ob >> 9) & 1) << 5)); }
__host__ __device__ __forceinline__ void stage_rc(int b, int& R, int& C) { const int st = b / 1024, sb = b % 1024, swz = sb ^ (((sb >> 9) & 1) << 5); R = (st >> 1) * 16 + swz / 64; C = (st & 1) * 32 + (swz % 64) / 2; }
__host__ __device__ __forceinline__ int perm32(int rho) { const int n = rho >> 4, i = rho & 15; return 8 * (i >> 2) + 4 * n + (i & 3); }

struct Unit { int pm, pn; };
struct Gemm { const bf16_t* A; const bf16_t* Bt; int M, N, K; };

struct StaticOrder {
    int nM, nN, nwg, G, c;
    __host__ __device__ void init(int M, int N, int G_, int c_) { nM = M / BM; nN = N / BM; nwg = nM * nN; G = G_; c = c_; }
    __host__ __device__ bool next(int i, Unit& u) const {
        const long L = (long)i * G + c; if (L >= nwg) return false;
        int wgid = (int)L; { const int q = nwg / NXCD, r = nwg % NXCD, xcd = wgid % NXCD, off = wgid / NXCD; wgid = (xcd < r ? xcd * (q + 1) : r * (q + 1) + (xcd - r) * q) + off; }
        const int nig = WGM * nN, gid = wgid / nig, fm = gid * WGM, gsz = (nM - fm) < WGM ? (nM - fm) : WGM;
        u.pm = fm + ((wgid % nig) % gsz); u.pn = (wgid % nig) / gsz; return true;
    }
    __device__ __forceinline__ void a_ready(const Unit&) const {}
    __device__ __forceinline__ void done(const Unit&) const {}
};
__device__ __forceinline__ unsigned cvt_pk_bf16(float lo, float hi) { unsigned r; asm volatile("v_cvt_pk_bf16_f32 %0, %1, %2" : "=v"(r) : "v"(lo), "v"(hi)); return r; }
typedef float f32x2 __attribute__((ext_vector_type(2)));
__device__ __forceinline__ f32x2 gelu_pk(f32x2 v) {
    const f32x2 av = __builtin_elementwise_abs(v), d = av * 0.2316418882f + 1.0f;
    f32x2 t; t.x = __builtin_amdgcn_rcpf(d.x); t.y = __builtin_amdgcn_rcpf(d.y);
    f32x2 q = t * 0.5307027145f + (-0.7265760135f); q = q * t + 0.7107068705f; q = q * t + (-0.142248368f); q = q * t + 0.127414796f; q = q * t;
    const f32x2 s = (v * v) * (-0.72134752044f);
    f32x2 e; e.x = __builtin_amdgcn_exp2f(s.x); e.y = __builtin_amdgcn_exp2f(s.y);
    const f32x2 m = v * (q * e), r = v - m;
    f32x2 o; o.x = v.x < 0.f ? m.x : r.x; o.y = v.y < 0.f ? m.y : r.y; return o;
}

struct EpiF32 {
    static constexpr bool PERM = false, AFTER_DRAIN = false;
    float* C; int ldc; const float* bias;
    __device__ __forceinline__ void operator()(const f32x4 (&acc)[2][2][4][2], const Unit& u, int wr, int wc, int fr, int fq) const {
        const int row0 = u.pm * BM + wr * 64 + fr, col0 = u.pn * BM + wc * 32 + 4 * fq;
        f32x4 bv[2][2];
#pragma unroll
        for (int bj = 0; bj < 2; ++bj)
#pragma unroll
            for (int n = 0; n < 2; ++n) bv[bj][n] = bias ? *(const f32x4*)(bias + col0 + bj * HALF + n * 16) : (f32x4){0.f, 0.f, 0.f, 0.f};
#pragma unroll
        for (int ai = 0; ai < 2; ++ai)
#pragma unroll
            for (int m = 0; m < 4; ++m) { float* rowp = C + (size_t)(row0 + ai * HALF + m * 16) * ldc + col0;
#pragma unroll
                for (int bj = 0; bj < 2; ++bj)
#pragma unroll
                    for (int n = 0; n < 2; ++n) *(f32x4*)(rowp + bj * HALF + n * 16) = acc[ai][bj][m][n] + bv[bj][n]; }
    }
};
template <int ACT  > struct EpiBf16 {
    static constexpr bool PERM = true, AFTER_DRAIN = false;
    bf16_t* O; int ldc; const float* bias; int split_cols; size_t split_stride;
    __device__ __forceinline__ void operator()(const f32x4 (&acc)[2][2][4][2], const Unit& u, int wr, int wc, int fr, int fq) const {
        const int row0 = u.pm * BM + wr * 64 + fr; int colt = u.pn * BM; bf16_t* base = O;
        if (split_cols) { const int t = colt / split_cols; base += (size_t)t * split_stride; colt -= t * split_cols; }
        const int col0 = colt + wc * 32 + 8 * fq, bcol0 = u.pn * BM + wc * 32 + 8 * fq;
        f32x4 bv[2][2];
#pragma unroll
        for (int bj = 0; bj < 2; ++bj)
#pragma unroll
            for (int n = 0; n < 2; ++n) bv[bj][n] = bias ? *(const f32x4*)(bias + bcol0 + bj * HALF + 4 * n) : (f32x4){0.f, 0.f, 0.f, 0.f};
#pragma unroll
        for (int ai = 0; ai < 2; ++ai)
#pragma unroll
            for (int m = 0; m < 4; ++m) { bf16_t* rowp = base + (size_t)(row0 + ai * HALF + m * 16) * ldc + col0;
#pragma unroll
                for (int bj = 0; bj < 2; ++bj) { f32x4 v0 = acc[ai][bj][m][0] + bv[bj][0], v1 = acc[ai][bj][m][1] + bv[bj][1];
                    if (ACT == 1) { f32x2 a = gelu_pk((f32x2){v0[0], v0[1]}), b = gelu_pk((f32x2){v0[2], v0[3]}), c = gelu_pk((f32x2){v1[0], v1[1]}), d = gelu_pk((f32x2){v1[2], v1[3]});
                        v0 = (f32x4){a.x, a.y, b.x, b.y}; v1 = (f32x4){c.x, c.y, d.x, d.y}; }
                    if (ACT == 2) {
#pragma unroll
                        for (int j = 0; j < 4; ++j) { v0[j] = 0.5f * v0[j] * (1.0f + erff(v0[j] * 0.70710678f)); v1[j] = 0.5f * v1[j] * (1.0f + erff(v1[j] * 0.70710678f)); } }
                    u32x4 w; w.x = cvt_pk_bf16(v0[0], v0[1]); w.y = cvt_pk_bf16(v0[2], v0[3]); w.z = cvt_pk_bf16(v1[0], v1[1]); w.w = cvt_pk_bf16(v1[2], v1[3]);
                    *(u32x4*)(rowp + bj * HALF) = w; } }
    }
};

template <class Epi, class Sched, bool STAMP = false, int AMAP = 0>
__device__ __forceinline__ void gemm_phase(PG8_LAS unsigned char* lds, const Gemm g, const Sched& S, const Epi& E, unsigned long long* stamps, const int wvi) {
    int tid; asm volatile("v_mbcnt_lo_u32_b32 %0, -1, 0\n\tv_mbcnt_hi_u32_b32 %0, -1, %0\n\tv_lshl_add_u32 %0, %1, 6, %0" : "=&v"(tid) : "s"(wvi)); const int wid = __builtin_amdgcn_readfirstlane(tid >> 6), lane = tid & 63, wr = wid >> 2, wc = wid & 3, fr = lane & 15, fq = lane >> 4;
    const int K = g.K, nt = K / BK;
    int ts_lo = 0, ts_hi = 0, nts = 0; const unsigned long long rt_entry = STAMP ? (unsigned long long)wall_clock64() : 0ull;
#define PG8_STAMP() do { if (STAMP && wid == 0 && nts < 64) { const unsigned long long _c = (unsigned long long)clock64(); \
        ts_lo = (lane == nts) ? (int)(unsigned)_c : ts_lo; ts_hi = (lane == nts) ? (int)(unsigned)(_c >> 32) : ts_hi; ++nts; } } while (0)
    PG8_STAMP();
    unsigned voffA[2], voffB[2];
#pragma unroll
    for (int i = 0; i < 2; ++i) { int R, C; stage_rc(tid * 16 + i * 8192, R, C); const int Rb = Epi::PERM ? ((R & ~31) + perm32(R & 31)) : R;
        voffA[i] = AMAP == 1 ? (unsigned)((62 * (R >> 6) + (R & 63)) * K + C) * 2u : (AMAP == 2 ? (unsigned)((128 * (R >> 6) + (R & 63)) * K + C) * 2u : (unsigned)(R * K + C) * 2u); voffB[i] = (unsigned)(Rb * K + C) * 2u; }
    const size_t kstep = (size_t)(BK * 2);
    const size_t hstep = (size_t)HALF * K * 2;
    const size_t tstep = 2 * hstep;
    const size_t hstepA = AMAP == 1 ? (size_t)124 * K * 2 : (AMAP == 2 ? (size_t)64 * K * 2 : hstep), tstepA = AMAP == 1 ? 2 * hstepA : tstep;
    const unsigned ldsw = (unsigned)wid * 1024u;
    const int aoff = lds_byte(wr * 64 + fr, fq * 8), boff = lds_byte(wc * 32 + fr, fq * 8);
#define PG8_SA(b, h) (((b) * 2 + (h)) * HTB)
#define PG8_SB(b, h) ((4 + (b) * 2 + (h)) * HTB)
#define PG8_STAGE(bufoff, gbase, voff) do { _Pragma("unroll") for (int _i = 0; _i < 2; ++_i) \
        __builtin_amdgcn_global_load_lds((const unsigned*)((const char*)(gbase) + (voff)[_i]), (PG8_LAS unsigned*)(lds + (bufoff) + ldsw + _i * 8192), 16, 0, 0); } while (0)
#define PG8_LDA(dst, b, h) do { _Pragma("unroll") for (int m = 0; m < 4; ++m) _Pragma("unroll") for (int k = 0; k < 2; ++k) dst[m][k] = *(const PG8_LAS bf16x8*)(lds + PG8_SA(b, h) + aoff + m * 2048 + k * 1024); } while (0)
#define PG8_LDB(dst, b, h) do { _Pragma("unroll") for (int n = 0; n < 2; ++n) _Pragma("unroll") for (int k = 0; k < 2; ++k) dst[n][k] = *(const PG8_LAS bf16x8*)(lds + PG8_SB(b, h) + boff + n * 2048 + k * 1024); } while (0)
#define PG8_MMA(ai, bj, At, Bt) do { __builtin_amdgcn_s_setprio(1); _Pragma("unroll") for (int m = 0; m < 4; ++m) _Pragma("unroll") for (int n = 0; n < 2; ++n) _Pragma("unroll") for (int k = 0; k < 2; ++k) \
        acc[ai][bj][m][n] = __builtin_amdgcn_mfma_f32_16x16x32_bf16(Bt[n][k], At[m][k], acc[ai][bj][m][n], 0, 0, 0); __builtin_amdgcn_s_setprio(0); } while (0)
#define PG8_WAIT_V(n) asm volatile("s_waitcnt vmcnt(" #n ")" ::: "memory")
#define PG8_WAIT_L(n) asm volatile("s_waitcnt lgkmcnt(" #n ")" ::: "memory")
#define PG8_BAR __builtin_amdgcn_s_barrier()
#define PG8_SCHED __builtin_amdgcn_sched_barrier(0)
    Unit cur, nxt; int ui = 0;
    if (!S.next(0, cur)) return;
    f32x4 acc[2][2][4][2];
#pragma unroll
    for (int a = 0; a < 2; ++a)
#pragma unroll
        for (int b = 0; b < 2; ++b)
#pragma unroll
            for (int m = 0; m < 4; ++m)
#pragma unroll
                for (int n = 0; n < 2; ++n) acc[a][b][m][n] = (f32x4){0.f, 0.f, 0.f, 0.f};
    bf16x8 At[4][2], B0[2][2], B1[2][2];
    const char* cA = (const char*)g.A + (size_t)cur.pm * tstepA; const char* cB = (const char*)g.Bt + (size_t)cur.pn * tstep;
    S.a_ready(cur);
    PG8_STAGE(PG8_SB(0, 0), cB, voffB); PG8_STAGE(PG8_SA(0, 0), cA, voffA); PG8_STAGE(PG8_SB(0, 1), cB + hstep, voffB); PG8_STAGE(PG8_SA(0, 1), cA + hstepA, voffA);
    if (wr == 1) PG8_BAR;
    PG8_WAIT_V(4); PG8_BAR;
    PG8_STAGE(PG8_SB(1, 0), cB + kstep, voffB); PG8_STAGE(PG8_SA(1, 0), cA + kstep, voffA); PG8_STAGE(PG8_SB(1, 1), cB + hstep + kstep, voffB);
    PG8_WAIT_V(6); PG8_BAR;
    PG8_STAMP();
    for (;;) {
        const bool has_next = S.next(ui + 1, nxt);
        const char* nA = has_next ? (const char*)g.A + (size_t)nxt.pm * tstepA : cA; const char* nB = has_next ? (const char*)g.Bt + (size_t)nxt.pn * tstep : cB;
        for (int t = 0; t < nt; t += 2) {
            const bool last = (t == nt - 2);
            const char* a1 = cA + (size_t)(t + 1) * kstep;
            const char* a2 = last ? nA : cA + (size_t)(t + 2) * kstep; const char* b2 = last ? nB : cB + (size_t)(t + 2) * kstep;
            const char* a3 = a2 + kstep; const char* b3 = b2 + kstep;
            if (last && has_next) S.a_ready(nxt);
            PG8_LDB(B0, 0, 0); PG8_SCHED; PG8_LDA(At, 0, 0); PG8_STAGE(PG8_SA(1, 1), a1 + hstepA, voffA);
            PG8_WAIT_L(8); PG8_BAR; PG8_WAIT_L(0); PG8_MMA(0, 0, At, B0); PG8_BAR; PG8_SCHED;
            PG8_LDB(B1, 0, 1); PG8_STAGE(PG8_SB(0, 0), b2, voffB);
            PG8_BAR; PG8_WAIT_L(0); PG8_MMA(0, 1, At, B1); PG8_BAR;
            PG8_LDA(At, 0, 1); PG8_STAGE(PG8_SA(0, 0), a2, voffA);
            PG8_BAR; PG8_WAIT_L(0); PG8_MMA(1, 0, At, B0); PG8_BAR; PG8_SCHED;
            PG8_STAGE(PG8_SB(0, 1), b2 + hstep, voffB);
            PG8_WAIT_V(6); PG8_BAR; PG8_MMA(1, 1, At, B1); PG8_BAR;
            PG8_LDB(B0, 1, 0); PG8_SCHED; PG8_LDA(At, 1, 0); PG8_STAGE(PG8_SA(0, 1), a2 + hstepA, voffA);
            PG8_WAIT_L(8); PG8_BAR; PG8_WAIT_L(0); PG8_MMA(0, 0, At, B0); PG8_BAR; PG8_SCHED;
            PG8_LDB(B1, 1, 1); PG8_STAGE(PG8_SB(1, 0), b3, voffB);
            PG8_BAR; PG8_WAIT_L(0); PG8_MMA(0, 1, At, B1); PG8_BAR;
            PG8_LDA(At, 1, 1); PG8_STAGE(PG8_SA(1, 0), a3, voffA);
            PG8_BAR; PG8_WAIT_L(0); PG8_MMA(1, 0, At, B0); PG8_BAR; PG8_SCHED;
            PG8_STAGE(PG8_SB(1, 1), b3 + hstep, voffB);
            PG8_WAIT_V(6); PG8_BAR; PG8_MMA(1, 1, At, B1); PG8_BAR;
        }
        PG8_STAMP();
        if constexpr (!Epi::AFTER_DRAIN) { E(acc, cur, wr, wc, fr, fq); S.done(cur); }
        PG8_STAMP();
        if (!has_next) break;
#pragma unroll
        for (int a = 0; a < 2; ++a)
#pragma unroll
            for (int b = 0; b < 2; ++b)
#pragma unroll
                for (int m = 0; m < 4; ++m)
#pragma unroll
                    for (int n = 0; n < 2; ++n) acc[a][b][m][n] = (f32x4){0.f, 0.f, 0.f, 0.f};
        cur = nxt; cA = nA; cB = nB; ++ui;
    }
    PG8_WAIT_V(0);
    if (wr == 0) PG8_BAR;
    PG8_BAR;
    if constexpr (Epi::AFTER_DRAIN) { E.fused(acc, cur, wr, wc, fr, fq, lds, wid, lane); S.done(cur); }
    PG8_STAMP();
    if (STAMP && wid == 0) { stamps[lane] = lane < nts ? (((unsigned long long)(unsigned)ts_hi << 32) | (unsigned)ts_lo) : 0ull;
        if (lane == 62) stamps[62] = rt_entry; if (lane == 63) stamps[63] = (unsigned long long)wall_clock64(); }
#undef PG8_STAMP
#undef PG8_SA
#undef PG8_SB
#undef PG8_STAGE
#undef PG8_LDA
#undef PG8_LDB
#undef PG8_MMA
#undef PG8_WAIT_V
#undef PG8_WAIT_L
#undef PG8_BAR
#undef PG8_SCHED
}
}
#define DI __device__ __forceinline__
#define LAS __attribute__((address_space(3)))
typedef unsigned short bf16_t;
typedef short bf16x8 __attribute__((ext_vector_type(8)));
typedef float f32x4 __attribute__((ext_vector_type(4)));
typedef unsigned u32x4 __attribute__((ext_vector_type(4)));
typedef unsigned u32x2 __attribute__((ext_vector_type(2)));
typedef LAS unsigned char* ldsp;

constexpr int MTOK = 32768, DM = 1024, SEQ = 4096;
constexpr int DFF = 2816, NUP = 5632;
constexpr int MHALF = 16384;
constexpr size_t MiB = 1048576;
constexpr size_t OFF_WA_IN = 0, OFF_WA_OUT = 8 * MiB + MiB / 2, OFF_WB_IN = OFF_WA_OUT + 2 * MiB, OFF_WB_OUT = OFF_WB_IN + 3 * MiB;
constexpr size_t OFF_WUP0 = OFF_WB_OUT + 2 * MiB, OFF_WUP1 = OFF_WUP0 + 11 * MiB, OFF_WDN0 = OFF_WUP1 + 11 * MiB, OFF_WDN1 = OFF_WDN0 + 5 * MiB + MiB / 2;
constexpr size_t OFF_WG0 = OFF_WDN1 + 5 * MiB + MiB / 2, OFF_WG1 = OFF_WG0 + 2 * MiB, OFF_WP0 = OFF_WG1 + 2 * MiB, OFF_WP1 = OFF_WP0 + MiB / 2;
constexpr size_t OFF_SSA = 54 * MiB, OFF_SSB = 56 * MiB, OFF_BA = 58 * MiB;
constexpr size_t OFF_HB = 60 * MiB;
constexpr size_t OFF_XQ = 124 * MiB, OFF_XK = 188 * MiB, OFF_XV = 252 * MiB, OFF_XZ = 316 * MiB;
constexpr size_t OFF_YK = 380 * MiB, OFF_YV = 444 * MiB;
constexpr size_t OFF_GL = 508 * MiB;
constexpr size_t OFF_RAW = 300 * MiB;
constexpr size_t OFF_ACT = 124 * MiB, OFF_PB = 388 * MiB, OFF_PP = 404 * MiB;
constexpr size_t OFF_HB2 = 124 * MiB;
constexpr size_t OFF_BQ = 188 * MiB, OFF_BK = 252 * MiB, OFF_BV = 268 * MiB, OFF_AO = 284 * MiB;
constexpr size_t OFF_BAR = 510 * MiB;
constexpr size_t WS_NEED = 510 * MiB + 65536;
constexpr int LDS_ST_OFF = 147456 - 16;
constexpr int LDS_BYTES = 147456;

struct Params { const float* in[20]; float* out; unsigned char* ws; };

DI unsigned char* opq(unsigned char* q) { unsigned long long v = (unsigned long long)q; asm volatile("" : "+s"(v)); return (unsigned char*)(__attribute__((address_space(1))) unsigned char*)v; }
DI int otid(int wvi) { int t; asm volatile("v_mbcnt_lo_u32_b32 %0, -1, 0\n\tv_mbcnt_hi_u32_b32 %0, -1, %0\n\tv_lshl_add_u32 %0, %1, 6, %0" : "=&v"(t) : "s"(wvi)); return t; }
DI float bf2f(bf16_t b) { return __uint_as_float(((unsigned)b) << 16); }
typedef __bf16 bf2_t __attribute__((ext_vector_type(2)));
DI unsigned pack2(float lo, float hi) { bf2_t v; v[0] = (__bf16)lo; v[1] = (__bf16)hi; return __builtin_bit_cast(unsigned, v); }
DI bf16_t f2bf(float f) { return __builtin_bit_cast(bf16_t, (__bf16)f); }
DI float lo2f(unsigned w) { return __uint_as_float(w << 16); }
DI float hi2f(unsigned w) { return __uint_as_float(w & 0xffff0000u); }
DI float wave_sum(float v) {
#pragma unroll
    for (int o = 32; o >= 1; o >>= 1) v += __shfl_xor(v, o);
    return v;
}
DI void lds_barrier() { asm volatile("s_waitcnt lgkmcnt(0)" ::: "memory"); __builtin_amdgcn_s_barrier(); asm volatile("" ::: "memory"); }
DI float sigmoidf_(float x) { return __builtin_amdgcn_rcpf(1.0f + __expf(-x)); }
DI float siluf_(float x) { return x * __builtin_amdgcn_rcpf(1.0f + __expf(-x)); }
DI float row_rstd(const float* __restrict__ ss, int row) { return rsqrtf(ss[row] * (1.0f / 1024.0f) + 1e-6f); }
#define MFMA16(a, b, c) __builtin_amdgcn_mfma_f32_16x16x32_bf16((a), (b), (c), 0, 0, 0)

#define XB_TMO      128
#define XB_XCNT(j)  (256  + 64 * (j))
#define XB_XSUB(j)  (1280 + 64 * (j))
#define XB_XGEN(j)  (2304 + 64 * (j))
#define XB_TOP      3328
#define XB_TOPGEN   3392
#define XCD_BAR_WORDS 3456
#define XB_SPIN_CAP (1u << 18)

__device__ __forceinline__ unsigned xb_ld(unsigned* p)              { return __hip_atomic_load(p, __ATOMIC_RELAXED, __HIP_MEMORY_SCOPE_AGENT); }
__device__ __forceinline__ unsigned xb_add(unsigned* p, unsigned v) { return __hip_atomic_fetch_add(p, v, __ATOMIC_RELAXED, __HIP_MEMORY_SCOPE_AGENT); }
__device__ __forceinline__ unsigned xb_xcc_id() { return (unsigned)__builtin_amdgcn_s_getreg((3 << 11) | 20) & 0xFu; }
#define XB_SPIN(cond, bar) do { unsigned _sp = 0; while (cond) { __builtin_amdgcn_s_sleep(1); \
    if ((++_sp & 255u) == 0u) { if (xb_ld(&(bar)[XB_TMO])) break; if (_sp > XB_SPIN_CAP) { atomicAdd(&(bar)[XB_TMO], 1u); break; } } } } while (0)

struct XcdBarrier {
    unsigned* bar; unsigned x; int wave;
    volatile LAS unsigned* st;
};

__device__ __forceinline__ XcdBarrier xcd_barrier_post(unsigned* bar, volatile LAS unsigned* st) {
    XcdBarrier b; b.bar = bar; b.x = xb_xcc_id(); b.st = st; b.wave = __builtin_amdgcn_readfirstlane((int)(threadIdx.x >> 6));
    if (threadIdx.x == 0) (void)xb_add(&bar[XB_XCNT(b.x)], 1u);
    return b;
}
__device__ __forceinline__ void xcd_barrier_complete(unsigned* bar, unsigned x, unsigned& nloc, unsigned& nx) {
    const unsigned G = gridDim.x * gridDim.y * gridDim.z;
    unsigned sum, cnt, mine, sp = 0u;
    for (;;) {
        sum = 0u; cnt = 0u; mine = 0u;
#pragma unroll
        for (unsigned j = 0; j < 16; ++j) { const unsigned c = xb_ld(&bar[XB_XCNT(j)]); sum += c; cnt += (c > 0u) ? 1u : 0u; mine = (j == x) ? c : mine; }
        if (sum == G) break;
        __builtin_amdgcn_s_sleep(1);
        if ((++sp & 255u) == 0u) { if (xb_ld(&bar[XB_TMO])) break; if (sp > XB_SPIN_CAP) { atomicAdd(&bar[XB_TMO], 1u); break; } }
    }
    nloc = mine > 0u ? mine : 1u; nx = cnt > 0u ? cnt : 1u;
}

__device__ __forceinline__ void xcd_barrier(const XcdBarrier& b) {
    asm volatile("s_waitcnt vmcnt(0)" ::: "memory");
    __syncthreads();
    if (b.wave == 0 && __builtin_amdgcn_mbcnt_hi(~0u, __builtin_amdgcn_mbcnt_lo(~0u, 0u)) == 0u) {
        unsigned* bar = b.bar;
        __builtin_amdgcn_s_waitcnt(0);
        unsigned nloc = b.st[0], nx = b.st[1];
        if (nloc == 0u) { xcd_barrier_complete(bar, b.x, nloc, nx); b.st[0] = nloc; b.st[1] = nx; }
        const unsigned old = xb_add(&bar[XB_XSUB(b.x)], 1u);
        const unsigned gen = old / nloc;
        if (old + 1u == (gen + 1u) * nloc) {
            __builtin_amdgcn_fence(__ATOMIC_RELEASE, "agent");
            asm volatile("s_waitcnt vmcnt(0)" ::: "memory");
            const unsigned og = xb_add(&bar[XB_TOP], 1u);
            const unsigned tg = og / nx;
            if (og + 1u == (tg + 1u) * nx) xb_add(&bar[XB_TOPGEN], 1u);
            else XB_SPIN(xb_ld(&bar[XB_TOPGEN]) == tg, bar);
            __builtin_amdgcn_fence(__ATOMIC_ACQUIRE, "agent");
            xb_add(&bar[XB_XGEN(b.x)], 1u);
            asm volatile("s_waitcnt vmcnt(0)" ::: "memory");
        } else {
            XB_SPIN(xb_ld(&bar[XB_XGEN(b.x)]) == gen, bar);
            __builtin_amdgcn_fence(__ATOMIC_ACQUIRE, "agent");
            asm volatile("s_waitcnt vmcnt(0)" ::: "memory");
        }
    }
    __syncthreads();
}


using pg8::Unit;
struct EpiProjA {
    static constexpr bool PERM = true, AFTER_DRAIN = false;
    bf16_t* X; float* ba; const float* ss;
    DI void operator()(const f32x4 (&acc)[2][2][4][2], const Unit& u, int wr, int wc, int fr, int fq) const {
        const int row0 = u.pm * 256 + wr * 64 + fr;
        float rsv[2][4];
#pragma unroll
        for (int ai = 0; ai < 2; ++ai)
#pragma unroll
            for (int m = 0; m < 4; ++m) rsv[ai][m] = ss[row0 + ai * 128 + m * 16];
        bf16_t* base = X + (size_t)(u.pn >> 2) * ((size_t)MTOK * 1024);
        const int col0 = (u.pn & 3) * 256 + wc * 32 + 8 * fq;
#pragma unroll
        for (int ai = 0; ai < 2; ++ai)
#pragma unroll
            for (int m = 0; m < 4; ++m) {
                const int row = row0 + ai * 128 + m * 16; const float rs = rsqrtf(rsv[ai][m] * (1.0f / 1024.0f) + 1e-6f);
                bf16_t* rowp = base + (size_t)row * 1024 + col0;
#pragma unroll
                for (int bj = 0; bj < 2; ++bj) { const f32x4 v0 = acc[ai][bj][m][0] * rs, v1 = acc[ai][bj][m][1] * rs;
                    u32x4 w; w.x = pack2(v0[0], v0[1]); w.y = pack2(v0[2], v0[3]); w.z = pack2(v1[0], v1[1]); w.w = pack2(v1[2], v1[3]);
                    *(u32x4*)(rowp + bj * 128) = w; }
            }
    }
};
struct EpiProjB {
    static constexpr bool PERM = true, AFTER_DRAIN = false;
    bf16_t* Q; bf16_t* K; bf16_t* V; const float* ss;
    DI void operator()(const f32x4 (&acc)[2][2][4][2], const Unit& u, int wr, int wc, int fr, int fq) const {
        const int row0 = u.pm * 256 + wr * 64 + fr;
        float rsv[2][4];
#pragma unroll
        for (int ai = 0; ai < 2; ++ai)
#pragma unroll
            for (int m = 0; m < 4; ++m) rsv[ai][m] = ss[row0 + ai * 128 + m * 16];
        bf16_t* base = u.pn < 4 ? Q + u.pn * 256 : (u.pn == 4 ? K : V);
        const int ld = u.pn < 4 ? 1024 : 256;
        const int col0 = wc * 32 + 8 * fq;
#pragma unroll
        for (int ai = 0; ai < 2; ++ai)
#pragma unroll
            for (int m = 0; m < 4; ++m) {
                const int row = row0 + ai * 128 + m * 16; const float rs = rsqrtf(rsv[ai][m] * (1.0f / 1024.0f) + 1e-6f);
                bf16_t* rowp = base + (size_t)row * ld + col0;
#pragma unroll
                for (int bj = 0; bj < 2; ++bj) { const f32x4 v0 = acc[ai][bj][m][0] * rs, v1 = acc[ai][bj][m][1] * rs;
                    u32x4 w; w.x = pack2(v0[0], v0[1]); w.y = pack2(v0[2], v0[3]); w.z = pack2(v1[0], v1[1]); w.w = pack2(v1[2], v1[3]);
                    *(u32x4*)(rowp + bj * 128) = w; }
            }
    }
};
struct EpiUp {
    static constexpr bool PERM = true, AFTER_DRAIN = false;
    bf16_t* U; const float* ss; int rowbase;
    DI void operator()(const f32x4 (&acc)[2][2][4][2], const Unit& u, int wr, int wc, int fr, int fq) const {
        const int row0 = u.pm * 256 + wr * 64 + fr; const int col0 = u.pn * 256 + wc * 32 + 8 * fq;
#pragma unroll
        for (int ai = 0; ai < 2; ++ai)
#pragma unroll
            for (int m = 0; m < 4; ++m) {
                const int row = row0 + ai * 128 + m * 16; const float rs = row_rstd(ss, rowbase + row);
                bf16_t* rowp = U + (size_t)row * NUP + col0;
#pragma unroll
                for (int bj = 0; bj < 2; ++bj) { const f32x4 v0 = acc[ai][bj][m][0] * rs, v1 = acc[ai][bj][m][1] * rs;
                    u32x4 w; w.x = pack2(v0[0], v0[1]); w.y = pack2(v0[2], v0[3]); w.z = pack2(v1[0], v1[1]); w.w = pack2(v1[2], v1[3]);
                    *(u32x4*)(rowp + bj * 128) = w; }
            }
    }
};
DI float dpp_ror1(float x) { return __builtin_bit_cast(float, __builtin_amdgcn_update_dpp(0, __builtin_bit_cast(int, x), 0x121, 0xf, 0xf, false)); }
DI float dpp_ror2(float x) { return __builtin_bit_cast(float, __builtin_amdgcn_update_dpp(0, __builtin_bit_cast(int, x), 0x122, 0xf, 0xf, false)); }
DI float dpp_shr1(float old, float x) { return __builtin_bit_cast(float, __builtin_amdgcn_update_dpp(__builtin_bit_cast(int, old), __builtin_bit_cast(int, x), 0x111, 0xf, 0xf, false)); }
DI float dpp_shr2(float old, float x) { return __builtin_bit_cast(float, __builtin_amdgcn_update_dpp(__builtin_bit_cast(int, old), __builtin_bit_cast(int, x), 0x112, 0xf, 0xf, false)); }
struct EpiUpAct {
    static constexpr bool PERM = true, AFTER_DRAIN = false;
    bf16_t* ACT; const float* ss; const float* cw; float* RAW;
    template <bool SS> DI void run(const f32x4 (&acc)[2][2][4][2], const Unit& u, int wr, int wc, int fr, int fq) const {
        const int colg = u.pn * 128 + wc * 32 + 8 * fq;
        const int tb = u.pm * 256 + wr * 128 + fr;
        float* rawb = RAW + (size_t)((u.pm * 2 + wr) * 4) * NUP;
        float rs[2][4];
#pragma unroll
        for (int ai = 0; ai < 2; ++ai)
#pragma unroll
            for (int m = 0; m < 4; ++m) rs[ai][m] = ss[tb + ai * 64 + 16 * m];
        f32x4 wg[2][3], wv[2][3];
#pragma unroll
        for (int n = 0; n < 2; ++n)
#pragma unroll
            for (int i = 0; i < 3; ++i) { wg[n][i] = *(const f32x4*)(cw + i * NUP + colg + 4 * n); wv[n][i] = *(const f32x4*)(cw + i * NUP + DFF + colg + 4 * n); }
#pragma unroll
        for (int ai = 0; ai < 2; ++ai)
#pragma unroll
            for (int m = 0; m < 4; ++m) rs[ai][m] = rsqrtf(rs[ai][m] * (1.0f / 1024.0f) + 1e-6f);
        if (fr < 2) {
#pragma unroll
            for (int bj = 0; bj < 2; ++bj)
#pragma unroll
                for (int n = 0; n < 2; ++n) *(f32x4*)(rawb + (size_t)fr * NUP + bj * DFF + colg + 4 * n) = acc[0][bj][0][n] * rs[0][0];
        }
        if (fr >= 14) {
#pragma unroll
            for (int bj = 0; bj < 2; ++bj)
#pragma unroll
                for (int n = 0; n < 2; ++n) *(f32x4*)(rawb + (size_t)(fr - 12) * NUP + bj * DFF + colg + 4 * n) = acc[1][bj][3][n] * rs[1][3];
        }
#pragma unroll
        for (int n = 0; n < 2; ++n) {
#pragma unroll
            for (int ai = 0; ai < 2; ++ai) {
                const int t0 = tb + ai * 64;
                float res[4][4];
#pragma unroll
                for (int j = 0; j < 4; ++j) {
                    float g[4], v[4];
                    float gp = 0.f, vp = 0.f;
#pragma unroll
                    for (int m = 0; m < 4; ++m) { g[m] = acc[ai][0][m][n][j] * rs[ai][m]; v[m] = acc[ai][1][m][n][j] * rs[ai][m]; }
                    if (ai == 1) { gp = acc[0][0][3][n][j] * rs[0][3]; vp = acc[0][1][3][n][j] * rs[0][3]; }
                    asm volatile("" : "+v"(g[0]), "+v"(g[1]), "+v"(g[2]), "+v"(g[3]), "+v"(v[0]), "+v"(v[1]), "+v"(v[2]), "+v"(v[3]), "+v"(gp), "+v"(vp));
                    float og1 = dpp_ror1(gp), og2 = dpp_ror2(gp), ov1 = dpp_ror1(vp), ov2 = dpp_ror2(vp);
#pragma unroll
                    for (int m = 0; m < 4; ++m) {
                        float pg1 = dpp_shr1(og1, g[m]), pg2 = dpp_shr2(og2, g[m]), pv1 = dpp_shr1(ov1, v[m]), pv2 = dpp_shr2(ov2, v[m]);
                        if (m < 3) { og1 = dpp_ror1(g[m]); og2 = dpp_ror2(g[m]); ov1 = dpp_ror1(v[m]); ov2 = dpp_ror2(v[m]); }
                        if (SS) { const int ts = (t0 + 16 * m) & (SEQ - 1);
                            if (ts < 1) { pg1 = 0.f; pv1 = 0.f; }
                            if (ts < 2) { pg2 = 0.f; pv2 = 0.f; } }
                        const float gate = wg[n][0][j] * pg2 + wg[n][1][j] * pg1 + wg[n][2][j] * g[m];
                        const float val = wv[n][0][j] * pv2 + wv[n][1][j] * pv1 + wv[n][2][j] * v[m];
                        res[m][j] = siluf_(gate) * val;
                    }
                    asm volatile("" : "+v"(res[0][j]), "+v"(res[1][j]), "+v"(res[2][j]), "+v"(res[3][j]));
                }
#pragma unroll
                for (int m = 0; m < 4; ++m) { const int tt = t0 + 16 * m; u32x2 w; w.x = pack2(res[m][0], res[m][1]); w.y = pack2(res[m][2], res[m][3]);
                    if (ai > 0 || m > 0 || fr >= 2) *(u32x2*)(ACT + (size_t)tt * DFF + colg + 4 * n) = w; }
            }
        }
    }
    DI void operator()(const f32x4 (&acc)[2][2][4][2], const Unit& u, int wr, int wc, int fr, int fq) const {
        run<true>(acc, u, wr, wc, fr, fq);
    }
};
DI void ffn_fixup_panel(const Params& p, int layer, int pm, const float* ss, int wvi) {
    unsigned char* ws = opq(p.ws);
    const float* RAW = (const float*)(ws + OFF_RAW); bf16_t* ACT = (bf16_t*)(ws + OFF_ACT); const float* cw = p.in[16] + (size_t)layer * 3 * NUP;
    for (int idx = otid(wvi); idx < DFF; idx += 512) {
        const int q = idx / (DFF / 4), c = (idx - q * (DFF / 4)) * 4, wr = q >> 1, r = q & 1;
        const int blk = pm * 2 + wr, t = blk * 128 + r, ts = t & (SEQ - 1);
        const float* cur = RAW + (size_t)(blk * 4 + r) * NUP;
        const float* p1 = r ? RAW + (size_t)(blk * 4) * NUP : RAW + (size_t)((blk - 1) * 4 + 3) * NUP;
        const float* p2 = r ? RAW + (size_t)((blk - 1) * 4 + 3) * NUP : RAW + (size_t)((blk - 1) * 4 + 2) * NUP;
        const f32x4 zero = {0.f, 0.f, 0.f, 0.f};
        const f32x4 g0 = *(const f32x4*)(cur + c), v0 = *(const f32x4*)(cur + DFF + c);
        f32x4 g1 = zero, v1 = zero, g2 = zero, v2 = zero;
        if (ts >= 1) { g1 = *(const f32x4*)(p1 + c); v1 = *(const f32x4*)(p1 + DFF + c); }
        if (ts >= 2) { g2 = *(const f32x4*)(p2 + c); v2 = *(const f32x4*)(p2 + DFF + c); }
        const f32x4 wg0 = *(const f32x4*)(cw + c), wg1 = *(const f32x4*)(cw + NUP + c), wg2 = *(const f32x4*)(cw + 2 * NUP + c);
        const f32x4 wv0 = *(const f32x4*)(cw + DFF + c), wv1 = *(const f32x4*)(cw + NUP + DFF + c), wv2 = *(const f32x4*)(cw + 2 * NUP + DFF + c);
        const f32x4 gate = wg0 * g2 + wg1 * g1 + wg2 * g0, val = wv0 * v2 + wv1 * v1 + wv2 * v0;
        u32x2 w; w.x = pack2(siluf_(gate[0]) * val[0], siluf_(gate[1]) * val[1]); w.y = pack2(siluf_(gate[2]) * val[2], siluf_(gate[3]) * val[3]);
        *(u32x2*)(ACT + (size_t)t * DFF + c) = w;
    }
}
struct EpiPlain {
    static constexpr bool PERM = false, AFTER_DRAIN = false;
    bf16_t* O;
    DI void operator()(const f32x4 (&acc)[2][2][4][2], const Unit& u, int wr, int wc, int fr, int fq) const {
        const int row0 = u.pm * 256 + wr * 64 + fr, col0 = u.pn * 256 + wc * 32 + 4 * fq;
#pragma unroll
        for (int ai = 0; ai < 2; ++ai)
#pragma unroll
            for (int m = 0; m < 4; ++m) { bf16_t* rowp = O + (size_t)(row0 + ai * 128 + m * 16) * 1024 + col0;
#pragma unroll
                for (int bj = 0; bj < 2; ++bj)
#pragma unroll
                    for (int n = 0; n < 2; ++n) { const f32x4 v = acc[ai][bj][m][n]; u32x2 w; w.x = pack2(v[0], v[1]); w.y = pack2(v[2], v[3]); *(u32x2*)(rowp + bj * 128 + n * 16) = w; }
            }
    }
};
struct EpiResidual {
    static constexpr bool PERM = false, AFTER_DRAIN = false;
    const float* hsrc; float* hdst; bf16_t* hb; float* ssout; int rowbase;
    DI void operator()(const f32x4 (&acc)[2][2][4][2], const Unit& u, int wr, int wc, int fr, int fq) const {
        const int row0 = rowbase + u.pm * 256 + wr * 64 + fr, col0 = u.pn * 256 + wc * 32 + 4 * fq;
#pragma unroll
        for (int ai = 0; ai < 2; ++ai)
#pragma unroll
            for (int mp = 0; mp < 2; ++mp) {
                f32x4 hv[2][2][2];
#pragma unroll
                for (int mm = 0; mm < 2; ++mm)
#pragma unroll
                    for (int bj = 0; bj < 2; ++bj)
#pragma unroll
                        for (int n = 0; n < 2; ++n) hv[mm][bj][n] = *(const f32x4*)(hsrc + (size_t)(row0 + ai * 128 + (2 * mp + mm) * 16) * 1024 + col0 + bj * 128 + n * 16);
#pragma unroll
                for (int mm = 0; mm < 2; ++mm) {
                    const int m = 2 * mp + mm, row = row0 + ai * 128 + m * 16; const size_t off = (size_t)row * 1024 + col0; float sq = 0.f;
#pragma unroll
                    for (int bj = 0; bj < 2; ++bj)
#pragma unroll
                        for (int n = 0; n < 2; ++n) {
                            const f32x4 o = hv[mm][bj][n] + acc[ai][bj][m][n];
                            *(f32x4*)(hdst + off + bj * 128 + n * 16) = o;
                            u32x2 w; w.x = pack2(o[0], o[1]); w.y = pack2(o[2], o[3]); *(u32x2*)(hb + off + bj * 128 + n * 16) = w;
                            sq += (o[0] * o[0] + o[1] * o[1]) + (o[2] * o[2] + o[3] * o[3]);
                        }
                    sq += __shfl_xor(sq, 16); sq += __shfl_xor(sq, 32);
                    if (fq == 0) unsafeAtomicAdd(ssout + row, sq);
                }
            }
    }
};
struct EpiPle {
    static constexpr bool PERM = false, AFTER_DRAIN = false;
    float* h; bf16_t* hb; const bf16_t* pp; const float* ssin; float* ssout;
    DI void operator()(const f32x4 (&acc)[2][2][4][2], const Unit& u, int wr, int wc, int fr, int fq) const {
        const int row0 = u.pm * 256 + wr * 64 + fr, col0 = u.pn * 256 + wc * 32 + 4 * fq;
#pragma unroll
        for (int ai = 0; ai < 2; ++ai)
#pragma unroll
            for (int mp = 0; mp < 2; ++mp) {
                f32x4 hv[2][2][2]; u32x2 pw[2][2][2]; float rsv[2];
#pragma unroll
                for (int mm = 0; mm < 2; ++mm) {
                    const int row = row0 + ai * 128 + (2 * mp + mm) * 16; rsv[mm] = ssin[row];
#pragma unroll
                    for (int bj = 0; bj < 2; ++bj)
#pragma unroll
                        for (int n = 0; n < 2; ++n) { const size_t o2 = (size_t)row * 1024 + col0 + bj * 128 + n * 16; hv[mm][bj][n] = *(const f32x4*)(h + o2); pw[mm][bj][n] = *(const u32x2*)(pp + o2); }
                }
#pragma unroll
                for (int mm = 0; mm < 2; ++mm) {
                    const int m = 2 * mp + mm, row = row0 + ai * 128 + m * 16; const size_t off = (size_t)row * 1024 + col0; float sq = 0.f;
                    const float rs = rsqrtf(rsv[mm] * (1.0f / 1024.0f) + 1e-6f);
#pragma unroll
                    for (int bj = 0; bj < 2; ++bj)
#pragma unroll
                        for (int n = 0; n < 2; ++n) {
                            const size_t o2 = off + bj * 128 + n * 16;
                            const f32x4 a = acc[ai][bj][m][n] * rs; const f32x4 hvv = hv[mm][bj][n]; const u32x2 pww = pw[mm][bj][n];
                            f32x4 o;
                            o[0] = hvv[0] + sigmoidf_(a[0]) * lo2f(pww.x); o[1] = hvv[1] + sigmoidf_(a[1]) * hi2f(pww.x);
                            o[2] = hvv[2] + sigmoidf_(a[2]) * lo2f(pww.y); o[3] = hvv[3] + sigmoidf_(a[3]) * hi2f(pww.y);
                            *(f32x4*)(h + o2) = o;
                            u32x2 w; w.x = pack2(o[0], o[1]); w.y = pack2(o[2], o[3]); *(u32x2*)(hb + o2) = w;
                            sq += (o[0] * o[0] + o[1] * o[1]) + (o[2] * o[2] + o[3] * o[3]);
                        }
                    sq += __shfl_xor(sq, 16); sq += __shfl_xor(sq, 32);
                    if (fq == 0) unsafeAtomicAdd(ssout + row, sq);
                }
            }
    }
};

template <class Epi> DI void run_gemm_amap(ldsp lds, int wvi, const bf16_t* A, const bf16_t* Bt, int Mtiles, int N, int K, const Epi& E) {
    pg8::Gemm g; g.A = A; g.Bt = Bt; g.M = Mtiles * 256; g.N = N; g.K = K;
    pg8::StaticOrder S; S.init(Mtiles * 256, N, (int)gridDim.x, (int)blockIdx.x);
    pg8::gemm_phase<Epi, pg8::StaticOrder, false, 2>(lds, g, S, E, nullptr, wvi);
}
template <class Epi> DI void run_gemm(ldsp lds, int wvi, const bf16_t* A, const bf16_t* Bt, int M, int N, int K, const Epi& E) {
    pg8::Gemm g; g.A = A; g.Bt = Bt; g.M = M; g.N = N; g.K = K;
    pg8::StaticOrder S; S.init(M, N, (int)gridDim.x, (int)blockIdx.x);
    pg8::gemm_phase<Epi, pg8::StaticOrder, false>(lds, g, S, E, nullptr, wvi);
}

template <bool UPPERM = false> DI void conv_w(const float* __restrict__ src, bf16_t* __restrict__ dst, const float* __restrict__ nw, int K, int N, int Npad, ldsp lds, int wvi) {
    LAS float* tile = (LAS float*)lds;
    const int tid = otid(wvi);
    const int nkt = K / 64, ntile = nkt * (Npad / 128);
    for (int t = blockIdx.x; t < ntile; t += gridDim.x) {
        const int kt = t % nkt, nt = t / nkt, k0 = kt * 64, n0 = nt * 128;
        f32x4 v[4]; float sc[4];
#pragma unroll
        for (int i = 0; i < 4; ++i) {
            const int idx = tid + i * 512, r = idx >> 5, c4 = idx & 31, n = n0 + 4 * c4;
            v[i] = (f32x4){0.f, 0.f, 0.f, 0.f};
            if (n < N) v[i] = *(const f32x4*)(src + (size_t)(k0 + r) * N + n);
            sc[i] = nw ? nw[k0 + r] : 1.0f;
        }
#pragma unroll
        for (int i = 0; i < 4; ++i) {
            const int idx = tid + i * 512, r = idx >> 5, c4 = idx & 31;
            tile[r * 129 + 4 * c4 + 0] = v[i][0] * sc[i]; tile[r * 129 + 4 * c4 + 1] = v[i][1] * sc[i]; tile[r * 129 + 4 * c4 + 2] = v[i][2] * sc[i]; tile[r * 129 + 4 * c4 + 3] = v[i][3] * sc[i];
        }
        lds_barrier();
#pragma unroll
        for (int i = 0; i < 2; ++i) {
            const int idx = tid + i * 512, rn = idx >> 3, ck = idx & 7; u32x4 w;
            w.x = pack2(tile[(8 * ck + 0) * 129 + rn], tile[(8 * ck + 1) * 129 + rn]); w.y = pack2(tile[(8 * ck + 2) * 129 + rn], tile[(8 * ck + 3) * 129 + rn]);
            w.z = pack2(tile[(8 * ck + 4) * 129 + rn], tile[(8 * ck + 5) * 129 + rn]); w.w = pack2(tile[(8 * ck + 6) * 129 + rn], tile[(8 * ck + 7) * 129 + rn]);
            const int nn = n0 + rn;
            const int rr = UPPERM ? (nn < DFF ? 256 * (nn >> 7) + (nn & 127) : 256 * ((nn - DFF) >> 7) + 128 + ((nn - DFF) & 127)) : nn;
            *(u32x4*)(dst + (size_t)rr * K + k0 + 8 * ck) = w;
        }
        lds_barrier();
    }
}
DI void phase_setup(const Params& p, ldsp lds, int wvi) {
    unsigned char* ws = opq(p.ws);
    conv_w(p.in[6], (bf16_t*)(ws + OFF_WA_IN), p.in[2], 1024, 4112, 4224, lds, wvi);
    conv_w(p.in[11], (bf16_t*)(ws + OFF_WA_OUT), nullptr, 1024, 1024, 1024, lds, wvi);
    conv_w(p.in[12], (bf16_t*)(ws + OFF_WB_IN), p.in[2] + 1024, 1024, 1536, 1536, lds, wvi);
    conv_w(p.in[14], (bf16_t*)(ws + OFF_WB_OUT), nullptr, 1024, 1024, 1024, lds, wvi);
    conv_w<true>(p.in[15], (bf16_t*)(ws + OFF_WUP0), p.in[3], 1024, NUP, NUP, lds, wvi);
    conv_w<true>(p.in[15] + (size_t)1024 * NUP, (bf16_t*)(ws + OFF_WUP1), p.in[3] + 1024, 1024, NUP, NUP, lds, wvi);
    conv_w(p.in[17], (bf16_t*)(ws + OFF_WDN0), nullptr, DFF, 1024, 1024, lds, wvi);
    conv_w(p.in[17] + (size_t)DFF * 1024, (bf16_t*)(ws + OFF_WDN1), nullptr, DFF, 1024, 1024, lds, wvi);
    conv_w(p.in[19], (bf16_t*)(ws + OFF_WG0), p.in[4], 1024, 1024, 1024, lds, wvi);
    conv_w(p.in[19] + (size_t)1024 * 1024, (bf16_t*)(ws + OFF_WG1), p.in[4] + 1024, 1024, 1024, 1024, lds, wvi);
    conv_w(p.in[18], (bf16_t*)(ws + OFF_WP0), nullptr, 256, 1024, 1024, lds, wvi);
    conv_w(p.in[18] + (size_t)256 * 1024, (bf16_t*)(ws + OFF_WP1), nullptr, 256, 1024, 1024, lds, wvi);
    const int tid0 = otid(wvi); const int lane = tid0 & 63, wid = tid0 >> 6;
    const float* x = p.in[0]; bf16_t* hb = (bf16_t*)(ws + OFF_HB); float* ssA = (float*)(ws + OFF_SSA);
    const int rstep = gridDim.x * 8;
    f32x4 nx[4];
#pragma unroll
    for (int i = 0; i < 4; ++i) nx[i] = *(const f32x4*)(x + (size_t)(blockIdx.x * 8 + wid) * 1024 + i * 256 + lane * 4);
    for (int row = blockIdx.x * 8 + wid; row < MTOK; row += rstep) {
        f32x4 v[4];
#pragma unroll
        for (int i = 0; i < 4; ++i) v[i] = nx[i];
        if (row + rstep < MTOK) {
#pragma unroll
            for (int i = 0; i < 4; ++i) nx[i] = *(const f32x4*)(x + (size_t)(row + rstep) * 1024 + i * 256 + lane * 4); }
        float sq = 0.f;
#pragma unroll
        for (int i = 0; i < 4; ++i) {
            const size_t off = (size_t)row * 1024 + i * 256 + lane * 4;
            sq += (v[i][0] * v[i][0] + v[i][1] * v[i][1]) + (v[i][2] * v[i][2] + v[i][3] * v[i][3]);
            u32x2 w; w.x = pack2(v[i][0], v[i][1]); w.y = pack2(v[i][2], v[i][3]); *(u32x2*)(hb + off) = w;
        }
        sq = wave_sum(sq);
        if (lane == 0) { ssA[row] = sq; ((float*)(ws + OFF_SSB))[row] = 0.f; }
    }
}

DI void phase_ba(const Params& p, const float* ss, int wvi) {
    unsigned char* ws = opq(p.ws);
    const int tid = otid(wvi), wid = tid >> 6, lane = tid & 63, fr = lane & 15, fq = lane >> 4;
    const bf16_t* hb = (const bf16_t*)(ws + OFF_HB); const bf16_t* W = (const bf16_t*)(ws + OFF_WA_IN) + (size_t)(4096 + fr) * 1024 + 8 * fq;
    float* ba = (float*)(ws + OFF_BA);
    for (int rt = blockIdx.x * 8 + wid; rt < MTOK / 16; rt += gridDim.x * 8) {
        const bf16_t* ap = hb + (size_t)(16 * rt + fr) * 1024 + 8 * fq;
        f32x4 acc = {0.f, 0.f, 0.f, 0.f};
#pragma unroll 8
        for (int ks = 0; ks < 32; ++ks) acc = MFMA16(*(const bf16x8*)(ap + 32 * ks), *(const bf16x8*)(W + 32 * ks), acc);
#pragma unroll
        for (int j = 0; j < 4; ++j) { const int row = 16 * rt + 4 * fq + j; ba[(size_t)row * 16 + fr] = acc[j] * row_rstd(ss, row); }
    }
}
DI void phase_conv_a(const Params& p, int wvi) {
    unsigned char* ws = opq(p.ws);
    const int tid0 = otid(wvi); const int lane = tid0 & 63, wid = tid0 >> 6;
    const float* aconv = p.in[7];
    for (int ui = blockIdx.x * 8 + wid; ui < 4096 * 3; ui += gridDim.x * 8) {
        const int tz = ui % 3, ch = ui / 3, n = ch & 63, bh = ch >> 6, h = bh & 7, b = bh >> 3;
        const bf16_t* X = (const bf16_t*)(ws + OFF_XQ) + (size_t)tz * ((size_t)MTOK * 1024);
        bf16_t* Y = (bf16_t*)(ws + (tz == 0 ? OFF_HB : (tz == 1 ? OFF_YK : OFF_YV))) + (size_t)ch * 8192;
        const int col = h * 128 + 2 * lane;
        float w[4][2];
#pragma unroll
        for (int i = 0; i < 4; ++i) { w[i][0] = aconv[i * 3072 + tz * 1024 + col]; w[i][1] = aconv[i * 3072 + tz * 1024 + col + 1]; }
        const size_t tok0 = (size_t)b * SEQ + n * 64;
        const unsigned* Xr = (const unsigned*)(X + tok0 * 1024 + col);
        float x0[2] = {0.f, 0.f}, x1[2] = {0.f, 0.f}, x2[2] = {0.f, 0.f};
        if (n > 0) { const unsigned a = *(Xr - 3 * 512), bb = *(Xr - 2 * 512), c = *(Xr - 512);
            x0[0] = lo2f(a); x0[1] = hi2f(a); x1[0] = lo2f(bb); x1[1] = hi2f(bb); x2[0] = lo2f(c); x2[1] = hi2f(c); }
        const float qs = tz == 0 ? 0.08838834764831845f : 1.0f;
        unsigned nxt[16];
#pragma unroll
        for (int i = 0; i < 16; ++i) nxt[i] = Xr[(size_t)i * 512];
        for (int i0 = 0; i0 < 64; i0 += 16) {
            unsigned cur[16];
#pragma unroll
            for (int i = 0; i < 16; ++i) cur[i] = nxt[i];
            if (i0 + 16 < 64) {
#pragma unroll
                for (int i = 0; i < 16; ++i) nxt[i] = Xr[(size_t)(i0 + 16 + i) * 512]; }
            float y0[16], y1[16];
#pragma unroll
            for (int i = 0; i < 16; ++i) {
                const float c0 = lo2f(cur[i]), c1 = hi2f(cur[i]);
                float a0 = w[0][0] * x0[0] + w[1][0] * x1[0] + w[2][0] * x2[0] + w[3][0] * c0;
                float a1 = w[0][1] * x0[1] + w[1][1] * x1[1] + w[2][1] * x2[1] + w[3][1] * c1;
                y0[i] = siluf_(a0); y1[i] = siluf_(a1);
                x0[0] = x1[0]; x0[1] = x1[1]; x1[0] = x2[0]; x1[1] = x2[1]; x2[0] = c0; x2[1] = c1;
            }
            if (tz < 2) {
#pragma unroll
                for (int i = 0; i < 16; ++i) { const float sq = wave_sum(y0[i] * y0[i] + y1[i] * y1[i]); const float r = rsqrtf(sq + 1e-6f) * qs; y0[i] *= r; y1[i] *= r; }
            }
#pragma unroll
            for (int i = 0; i < 16; ++i) *(unsigned*)(Y + (size_t)(i0 + i) * 128 + 2 * lane) = pack2(y0[i], y1[i]);
        }
    }
}

DI int frag_off(int r, int k, int kblocks) { return ((r >> 4) * kblocks + (k >> 5)) * 512 + ((((k & 31) >> 3) * 16 + (r & 15)) << 3) + (k & 7); }
DI int u0_off(int dv, int i) { return ((dv >> 4) * 4 + (i >> 4)) * 256 + (((((i & 15) >> 2) * 16) + (dv & 15)) << 2) + (i & 3); }
constexpr int PREP_TILE = 67 * 272;
constexpr int PREP_HALF = 3 * PREP_TILE + 16384 + 1280;
DI void phase_prep(const Params& p, ldsp lds0, int wvi) {
    unsigned char* ws = opq(p.ws);
    const int tid = otid(wvi), half = tid >> 8, lt = tid & 255, lw = lt >> 6, lane = tid & 63, fr = lane & 15, fq = lane >> 4;
    const float* ba = (const float*)(ws + OFF_BA);
    for (int u0 = blockIdx.x * 2; u0 < 4096; u0 += gridDim.x * 2) {
        int lofs = half * PREP_HALF; asm volatile("" : "+v"(lofs));
        ldsp lds = lds0 + lofs;
        LAS bf16_t* sQ = (LAS bf16_t*)lds + 3 * 136; LAS bf16_t* sK = (LAS bf16_t*)(lds + PREP_TILE) + 3 * 136; LAS bf16_t* sV = (LAS bf16_t*)(lds + 2 * PREP_TILE) + 3 * 136;
        LAS float* sL = (LAS float*)(lds + 3 * PREP_TILE); LAS float* sG = (LAS float*)(lds + 3 * PREP_TILE + 16384);
        LAS float* gcs = sG; LAS float* sbeta = sG + 64; LAS float* egcs = sG + 128; LAS float* ek = sG + 192; LAS float* bk = sG + 256;
        const int ch = u0 + half, n = ch & 63, bh = ch >> 6, h = bh & 7, b = bh >> 3;
        bf16_t* Yq = (bf16_t*)(ws + OFF_HB) + (size_t)ch * 8192; bf16_t* Yk = (bf16_t*)(ws + OFF_YK) + (size_t)ch * 8192; bf16_t* Yv = (bf16_t*)(ws + OFF_YV) + (size_t)ch * 8192;
        bf16_t* WK = (bf16_t*)p.out + (size_t)ch * 8192; bf16_t* QK = (bf16_t*)p.out + (size_t)MTOK * 1024 + (size_t)ch * 4096;
        { const size_t tok0 = (size_t)b * SEQ + n * 64;
          const bf16_t* Xb = (const bf16_t*)(ws + OFF_XQ) + tok0 * 1024 + h * 128;
          u32x4 vq[4], vk[4], vv[4], vh = {0u, 0u, 0u, 0u};
#pragma unroll
          for (int ps = 0; ps < 4; ++ps) { const int idx = lt + ps * 256, row = idx >> 4, c8 = idx & 15; const bf16_t* xp = Xb + (size_t)row * 1024 + 8 * c8;
              vq[ps] = *(const u32x4*)xp; vk[ps] = *(const u32x4*)(xp + (size_t)MTOK * 1024); vv[ps] = *(const u32x4*)(xp + (size_t)2 * MTOK * 1024); }
          const int htz = lt / 48, hr = (lt % 48) >> 4, hc8 = lt & 15;
          if (lt < 144 && n > 0) vh = *(const u32x4*)(Xb + (size_t)htz * MTOK * 1024 - (size_t)(3 - hr) * 1024 + 8 * hc8);
          asm volatile("" ::: "memory");
#pragma unroll
          for (int ps = 0; ps < 4; ++ps) { const int idx = lt + ps * 256, row = idx >> 4, c8 = idx & 15;
              *(LAS u32x4*)(sQ + row * 136 + 8 * c8) = vq[ps]; *(LAS u32x4*)(sK + row * 136 + 8 * c8) = vk[ps]; *(LAS u32x4*)(sV + row * 136 + 8 * c8) = vv[ps]; }
          if (lt < 144) *(LAS u32x4*)((LAS bf16_t*)(lds + htz * PREP_TILE) + hr * 136 + 8 * hc8) = vh;
        }
        lds_barrier();
        if (lt < 192) {
            const int tz = lt >> 6, pr = lt & 63;
            LAS unsigned* col = (LAS unsigned*)((LAS bf16_t*)(lds + tz * PREP_TILE) + 2 * pr);
            const float* cwp = p.in[7] + tz * 1024 + h * 128 + 2 * pr;
            float w0[4], w1[4];
#pragma unroll
            for (int i = 0; i < 4; ++i) { w0[i] = cwp[i * 3072]; w1[i] = cwp[i * 3072 + 1]; }
            unsigned r0 = col[0], r1 = col[68], r2 = col[2 * 68];
#pragma unroll 8
            for (int i = 0; i < 64; ++i) {
                const unsigned c = col[(i + 3) * 68];
                const float y0 = w0[0] * lo2f(r0) + w0[1] * lo2f(r1) + w0[2] * lo2f(r2) + w0[3] * lo2f(c);
                const float y1 = w1[0] * hi2f(r0) + w1[1] * hi2f(r1) + w1[2] * hi2f(r2) + w1[3] * hi2f(c);
                col[(i + 3) * 68] = pack2(siluf_(y0), siluf_(y1));
                r0 = r1; r1 = r2; r2 = c;
            }
        }
        lds_barrier();
        {
            const int row = lt >> 2, qt = lt & 3;
            LAS u32x4* qp = (LAS u32x4*)(sQ + row * 136 + 32 * qt); LAS u32x4* kp = (LAS u32x4*)(sK + row * 136 + 32 * qt);
            u32x4 qv[4], kv[4]; float sq = 0.f, sk = 0.f;
#pragma unroll
            for (int e = 0; e < 4; ++e) { qv[e] = qp[e]; kv[e] = kp[e];
                const unsigned qw[4] = {qv[e].x, qv[e].y, qv[e].z, qv[e].w}, kw[4] = {kv[e].x, kv[e].y, kv[e].z, kv[e].w};
#pragma unroll
                for (int t = 0; t < 4; ++t) { sq += lo2f(qw[t]) * lo2f(qw[t]) + hi2f(qw[t]) * hi2f(qw[t]); sk += lo2f(kw[t]) * lo2f(kw[t]) + hi2f(kw[t]) * hi2f(kw[t]); } }
            sq += __shfl_xor(sq, 1); sq += __shfl_xor(sq, 2); sk += __shfl_xor(sk, 1); sk += __shfl_xor(sk, 2);
            const float rq = rsqrtf(sq + 1e-6f) * 0.08838834764831845f, rk = rsqrtf(sk + 1e-6f);
#pragma unroll
            for (int e = 0; e < 4; ++e) { u32x4 a, c2;
                a.x = pack2(lo2f(qv[e].x) * rq, hi2f(qv[e].x) * rq); a.y = pack2(lo2f(qv[e].y) * rq, hi2f(qv[e].y) * rq); a.z = pack2(lo2f(qv[e].z) * rq, hi2f(qv[e].z) * rq); a.w = pack2(lo2f(qv[e].w) * rq, hi2f(qv[e].w) * rq);
                c2.x = pack2(lo2f(kv[e].x) * rk, hi2f(kv[e].x) * rk); c2.y = pack2(lo2f(kv[e].y) * rk, hi2f(kv[e].y) * rk); c2.z = pack2(lo2f(kv[e].z) * rk, hi2f(kv[e].z) * rk); c2.w = pack2(lo2f(kv[e].w) * rk, hi2f(kv[e].w) * rk);
                qp[e] = a; kp[e] = c2; }
        }
        if (lw == 0) {
            const size_t tok = (size_t)b * SEQ + n * 64 + lane;
            const float bl = ba[tok * 16 + h], ain = ba[tok * 16 + 8 + h];
            const float beta = sigmoidf_(bl);
            const float xsp = ain + p.in[9][h];
            const float ey = __expf(xsp);
            const float sp = xsp > 20.f ? xsp : (ey < 0.01f ? ey * (1.0f - ey * (0.5f - ey * 0.33333333f)) : __logf(1.0f + ey));
            float g = -__expf(p.in[8][h]) * sp;
#pragma unroll
            for (int o = 1; o < 64; o <<= 1) { const float t = __shfl_up(g, o); if (lane >= o) g += t; }
            const float glast = __shfl(g, 63);
            const float eg = __expf(g);
            gcs[lane] = g; sbeta[lane] = beta; egcs[lane] = eg; ek[lane] = __expf(glast - g); bk[lane] = beta * eg;
        }
        lds_barrier();
        {
            const int mi = lw;
            bf16x8 ak[4], aq[4];
#pragma unroll
            for (int ks = 0; ks < 4; ++ks) { ak[ks] = *(const LAS bf16x8*)(sK + (16 * mi + fr) * 136 + 32 * ks + 8 * fq); aq[ks] = *(const LAS bf16x8*)(sQ + (16 * mi + fr) * 136 + 32 * ks + 8 * fq); }
#pragma unroll
            for (int nj = 0; nj < 4; ++nj) {
                f32x4 akk = {0.f, 0.f, 0.f, 0.f}, aqk = {0.f, 0.f, 0.f, 0.f};
                if (nj <= mi) {
#pragma unroll
                    for (int ks = 0; ks < 4; ++ks) { const bf16x8 bkf = *(const LAS bf16x8*)(sK + (16 * nj + fr) * 136 + 32 * ks + 8 * fq); akk = MFMA16(ak[ks], bkf, akk); aqk = MFMA16(aq[ks], bkf, aqk); }
                }
                const int jj = 16 * nj + fr; const float gj = gcs[jj];
#pragma unroll
                for (int j = 0; j < 4; ++j) {
                    const int i = 16 * mi + 4 * fq + j; const float gi = gcs[i];
                    const float dec = jj <= i ? __expf(gi - gj) : 0.f;
                    sL[i * 64 + jj] = jj < i ? sbeta[i] * akk[j] * dec : 0.f;
                    QK[frag_off(i, jj, 2)] = f2bf(jj <= i ? aqk[j] * dec : 0.f);
                }
            }
        }
        lds_barrier();
        {
            const bool isv = lt < 128; const int cc = lt & 127;
            LAS bf16_t* srcT = isv ? sV : sK; LAS float* scl = isv ? sbeta : bk;
            float x[64];
#pragma unroll
            for (int ib = 0; ib < 16; ++ib) {
                const int i = 4 * ib;
                f32x4 s[4];
#pragma unroll
                for (int r = 0; r < 4; ++r) s[r] = (f32x4){0.f, 0.f, 0.f, 0.f};
#pragma unroll
                for (int j4 = 0; j4 < ib; ++j4) {
#pragma unroll
                    for (int r = 0; r < 4; ++r) { const f32x4 l = *(const LAS f32x4*)(sL + (i + r) * 64 + 4 * j4);
                        s[r][0] += l[0] * x[4 * j4]; s[r][1] += l[1] * x[4 * j4 + 1]; s[r][2] += l[2] * x[4 * j4 + 2]; s[r][3] += l[3] * x[4 * j4 + 3]; }
                    if ((j4 & 1) == 1) asm volatile("" ::: "memory");
                }
                f32x4 d[4]; float rh[4];
#pragma unroll
                for (int r = 0; r < 4; ++r) { d[r] = *(const LAS f32x4*)(sL + (i + r) * 64 + i); rh[r] = bf2f(srcT[(i + r) * 136 + cc]) * scl[i + r] - ((s[r][0] + s[r][1]) + (s[r][2] + s[r][3])); }
                x[i] = rh[0];
                x[i + 1] = rh[1] - d[1][0] * x[i];
                x[i + 2] = rh[2] - d[2][0] * x[i] - d[2][1] * x[i + 1];
                x[i + 3] = rh[3] - d[3][0] * x[i] - d[3][1] * x[i + 1] - d[3][2] * x[i + 2];
                asm volatile("" ::: "memory");
            }
            if (isv) {
#pragma unroll
                for (int g4 = 0; g4 < 16; ++g4) { u32x2 w; w.x = pack2(x[4 * g4], x[4 * g4 + 1]); w.y = pack2(x[4 * g4 + 2], x[4 * g4 + 3]);
                    *(u32x2*)(Yv + u0_off(cc, 4 * g4)) = w; }
            }
            lds_barrier();
            if (!isv) {
#pragma unroll
                for (int i = 0; i < 64; ++i) sV[i * 136 + cc] = f2bf(x[i]);
            }
        }
        lds_barrier();
#pragma unroll
        for (int ps = 0; ps < 4; ++ps) { const int idx = lt + ps * 256, row = idx >> 4, c8 = idx & 15; *(u32x4*)(WK + frag_off(row, 8 * c8, 4)) = *(const LAS u32x4*)(sV + row * 136 + 8 * c8); }
#pragma unroll
        for (int ps = 0; ps < 4; ++ps) {
            const int idx = lt + ps * 256;
            { const int row = idx >> 4, c8 = idx & 15; const float e = egcs[row]; const u32x4 v = *(const LAS u32x4*)(sQ + row * 136 + 8 * c8); u32x4 w;
              w.x = pack2(lo2f(v.x) * e, hi2f(v.x) * e); w.y = pack2(lo2f(v.y) * e, hi2f(v.y) * e); w.z = pack2(lo2f(v.z) * e, hi2f(v.z) * e); w.w = pack2(lo2f(v.w) * e, hi2f(v.w) * e);
              *(u32x4*)(Yq + frag_off(row, 8 * c8, 4)) = w; }
            { const int d = idx >> 3, i8 = idx & 7; float v[8];
#pragma unroll
              for (int e = 0; e < 8; ++e) v[e] = bf2f(sK[(8 * i8 + e) * 136 + d]) * ek[8 * i8 + e];
              u32x4 w; w.x = pack2(v[0], v[1]); w.y = pack2(v[2], v[3]); w.z = pack2(v[4], v[5]); w.w = pack2(v[6], v[7]);
              *(u32x4*)(Yk + frag_off(d, 8 * i8, 2)) = w; }
        }
        if (lt == 0) ((float*)(ws + OFF_GL))[ch] = egcs[63];
        lds_barrier();
    }
}

DI void phase_scan(const Params& p, ldsp lds, int wvi) {
    unsigned char* ws = opq(p.ws);
    const int tid = otid(wvi), wid = tid >> 6, lane = tid & 63, fr = lane & 15, fq = lane >> 4, kind = wid >> 2, mi = wid & 3;
    LAS bf16_t* sST = (LAS bf16_t*)lds;
    LAS bf16_t* sUT = (LAS bf16_t*)(lds + 32 * 272);
    for (int un = blockIdx.x; un < 256; un += gridDim.x) {
        const int sl = (un >> 3) & 3, bh = (un & 7) * 8 + (un >> 5), h = bh & 7, b = bh >> 3;
        const bf16_t* pA = (kind ? (const bf16_t*)(ws + OFF_HB) : (const bf16_t*)p.out) + (size_t)bh * 64 * 8192 + mi * 4 * 512 + lane * 8;
        const bf16_t* pK = (const bf16_t*)(ws + OFF_YK) + (size_t)bh * 64 * 8192 + wid * 2 * 512 + lane * 8;
        const bf16_t* pQK = (const bf16_t*)p.out + (size_t)MTOK * 1024 + (size_t)bh * 64 * 4096 + mi * 2 * 512 + lane * 8;
        const bf16_t* pU0 = (const bf16_t*)(ws + OFF_YV) + (size_t)bh * 64 * 8192 + ((sl * 2) * 4 + mi) * 256 + lane * 4;
        const float* GL = (const float*)(ws + OFF_GL) + bh * 64;
        bf16_t* O = (bf16_t*)(ws + OFF_XQ) + ((size_t)b * SEQ + 16 * mi + 4 * fq) * 1024 + h * 128 + sl * 32 + fr;
        for (int i = tid; i < 32 * 136 / 2; i += 512) ((LAS unsigned*)sST)[i] = 0u;
        f32x4 Sacc[2] = {{0.f, 0.f, 0.f, 0.f}, {0.f, 0.f, 0.f, 0.f}};
        bf16x8 fA[4][4]; u32x4 fB[4][2]; u32x2 fU[4][2]; bf16x8 fK[4][2]; float fg[4];
#define SCAN_LOAD(s, nn) do { \
            _Pragma("unroll") for (int ks = 0; ks < 4; ++ks) fA[s][ks] = *(const bf16x8*)(pA + (size_t)(nn) * 8192 + 512 * ks); \
            _Pragma("unroll") for (int ks = 0; ks < 2; ++ks) fK[s][ks] = *(const bf16x8*)(pK + (size_t)(nn) * 8192 + 512 * ks); \
            if (kind) { fB[s][0] = *(const u32x4*)(pQK + (size_t)(nn) * 4096); fB[s][1] = *(const u32x4*)(pQK + (size_t)(nn) * 4096 + 512); } \
            else { fU[s][0] = *(const u32x2*)(pU0 + (size_t)(nn) * 8192); fU[s][1] = *(const u32x2*)(pU0 + (size_t)(nn) * 8192 + 4 * 256); } \
            fg[s] = GL[nn]; } while (0)
        SCAN_LOAD(0, 0); SCAN_LOAD(1, 1); SCAN_LOAD(2, 2);
        lds_barrier();
        for (int n0 = 0; n0 < 64; n0 += 4) {
#pragma unroll
            for (int s = 0; s < 4; ++s) {
                const int n = n0 + s;
                SCAN_LOAD((s + 3) & 3, (n + 3 < 64 ? n + 3 : 63));
                f32x4 a0 = {0.f, 0.f, 0.f, 0.f}, a1 = {0.f, 0.f, 0.f, 0.f};
#pragma unroll
                for (int ks = 0; ks < 4; ++ks) {
                    const bf16x8 st0 = *(const LAS bf16x8*)(sST + fr * 136 + 32 * ks + 8 * fq), st1 = *(const LAS bf16x8*)(sST + (16 + fr) * 136 + 32 * ks + 8 * fq);
                    a0 = MFMA16(fA[s][ks], st0, a0); a1 = MFMA16(fA[s][ks], st1, a1);
                }
                if (!kind) {
                    const u32x2 ua = fU[s][0], ub = fU[s][1];
                    u32x2 w0, w1;
                    w0.x = pack2(lo2f(ua.x) - a0[0], hi2f(ua.x) - a0[1]); w0.y = pack2(lo2f(ua.y) - a0[2], hi2f(ua.y) - a0[3]);
                    w1.x = pack2(lo2f(ub.x) - a1[0], hi2f(ub.x) - a1[1]); w1.y = pack2(lo2f(ub.y) - a1[2], hi2f(ub.y) - a1[3]);
                    *(LAS u32x2*)(sUT + fr * 72 + 16 * mi + 4 * fq) = w0; *(LAS u32x2*)(sUT + (16 + fr) * 72 + 16 * mi + 4 * fq) = w1;
                }
                lds_barrier();
                bf16x8 ut0[2], ut1[2];
#pragma unroll
                for (int ks = 0; ks < 2; ++ks) { ut0[ks] = *(const LAS bf16x8*)(sUT + fr * 72 + 32 * ks + 8 * fq); ut1[ks] = *(const LAS bf16x8*)(sUT + (16 + fr) * 72 + 32 * ks + 8 * fq); }
                if (kind) {
#pragma unroll
                    for (int ks = 0; ks < 2; ++ks) { const bf16x8 qk = __builtin_bit_cast(bf16x8, fB[s][ks]); a0 = MFMA16(qk, ut0[ks], a0); a1 = MFMA16(qk, ut1[ks], a1); }
                    bf16_t* op = O + (size_t)n * 64 * 1024;
#pragma unroll
                    for (int j = 0; j < 4; ++j) { op[(size_t)j * 1024] = f2bf(a0[j]); op[(size_t)j * 1024 + 16] = f2bf(a1[j]); }
                }
                const float cgl = fg[s];
                Sacc[0] *= cgl; Sacc[1] *= cgl;
#pragma unroll
                for (int ks = 0; ks < 2; ++ks) { Sacc[0] = MFMA16(fK[s][ks], ut0[ks], Sacc[0]); Sacc[1] = MFMA16(fK[s][ks], ut1[ks], Sacc[1]); }
#pragma unroll
                for (int nv = 0; nv < 2; ++nv) { u32x2 w; w.x = pack2(Sacc[nv][0], Sacc[nv][1]); w.y = pack2(Sacc[nv][2], Sacc[nv][3]); *(LAS u32x2*)(sST + (16 * nv + fr) * 136 + 16 * wid + 4 * fq) = w; }
                lds_barrier();
            }
        }
#undef SCAN_LOAD
    }
}

DI void phase_gate(const Params& p, int wvi) {
    unsigned char* ws = opq(p.ws);
    const int tid0 = otid(wvi); const int lane = tid0 & 63, wid = tid0 >> 6;
    bf16_t* O = (bf16_t*)(ws + OFF_XQ); const bf16_t* Z = (const bf16_t*)(ws + OFF_XZ);
    const float* nw = p.in[10];
    float wv[16];
#pragma unroll
    for (int e = 0; e < 16; ++e) wv[e] = nw[(lane & 7) * 16 + e];
    const int rstep = gridDim.x * 8;
    u32x4 no0, no1, nz0, nz1;
    { const size_t off = (size_t)(blockIdx.x * 8 + wid) * 1024 + lane * 16; no0 = *(const u32x4*)(O + off); no1 = *(const u32x4*)(O + off + 8); nz0 = *(const u32x4*)(Z + off); nz1 = *(const u32x4*)(Z + off + 8); }
    for (int row = blockIdx.x * 8 + wid; row < MTOK; row += rstep) {
        const size_t off = (size_t)row * 1024 + lane * 16;
        const u32x4 o0 = no0, o1 = no1, z0 = nz0, z1 = nz1;
        if (row + rstep < MTOK) { const size_t o2 = off + (size_t)rstep * 1024; no0 = *(const u32x4*)(O + o2); no1 = *(const u32x4*)(O + o2 + 8); nz0 = *(const u32x4*)(Z + o2); nz1 = *(const u32x4*)(Z + o2 + 8); }
        float ov[16], zv[16];
        ov[0] = lo2f(o0.x); ov[1] = hi2f(o0.x); ov[2] = lo2f(o0.y); ov[3] = hi2f(o0.y); ov[4] = lo2f(o0.z); ov[5] = hi2f(o0.z); ov[6] = lo2f(o0.w); ov[7] = hi2f(o0.w);
        ov[8] = lo2f(o1.x); ov[9] = hi2f(o1.x); ov[10] = lo2f(o1.y); ov[11] = hi2f(o1.y); ov[12] = lo2f(o1.z); ov[13] = hi2f(o1.z); ov[14] = lo2f(o1.w); ov[15] = hi2f(o1.w);
        zv[0] = lo2f(z0.x); zv[1] = hi2f(z0.x); zv[2] = lo2f(z0.y); zv[3] = hi2f(z0.y); zv[4] = lo2f(z0.z); zv[5] = hi2f(z0.z); zv[6] = lo2f(z0.w); zv[7] = hi2f(z0.w);
        zv[8] = lo2f(z1.x); zv[9] = hi2f(z1.x); zv[10] = lo2f(z1.y); zv[11] = hi2f(z1.y); zv[12] = lo2f(z1.z); zv[13] = hi2f(z1.z); zv[14] = lo2f(z1.w); zv[15] = hi2f(z1.w);
        float sq = 0.f;
#pragma unroll
        for (int e = 0; e < 16; ++e) sq += ov[e] * ov[e];
        sq += __shfl_xor(sq, 1); sq += __shfl_xor(sq, 2); sq += __shfl_xor(sq, 4);
        const float rs = rsqrtf(sq * (1.0f / 128.0f) + 1e-6f);
        float r[16];
#pragma unroll
        for (int e = 0; e < 16; ++e) r[e] = ov[e] * rs * wv[e] * siluf_(zv[e]);
        u32x4 w0, w1;
        w0.x = pack2(r[0], r[1]); w0.y = pack2(r[2], r[3]); w0.z = pack2(r[4], r[5]); w0.w = pack2(r[6], r[7]);
        w1.x = pack2(r[8], r[9]); w1.y = pack2(r[10], r[11]); w1.z = pack2(r[12], r[13]); w1.w = pack2(r[14], r[15]);
        *(u32x4*)(O + off) = w0; *(u32x4*)(O + off + 8) = w1;
    }
}

DI void zero_ss(float* s, int wvi) { for (int i = blockIdx.x * 512 + otid(wvi); i < MTOK; i += gridDim.x * 512) s[i] = 0.f; }
DI void phase_convert_p(const Params& p, int layer, int wvi) {
    unsigned char* ws = opq(p.ws);
    const int gt = blockIdx.x * 512 + otid(wvi), nth = gridDim.x * 512;
    const float* ps = p.in[1] + (size_t)layer * MTOK * 256; bf16_t* pb = (bf16_t*)(ws + OFF_PB);
    for (size_t i = (size_t)gt * 8; i < (size_t)MTOK * 256; i += (size_t)nth * 8) {
        const f32x4 a = *(const f32x4*)(ps + i), b = *(const f32x4*)(ps + i + 4);
        u32x4 w; w.x = pack2(a[0], a[1]); w.y = pack2(a[2], a[3]); w.z = pack2(b[0], b[1]); w.w = pack2(b[2], b[3]);
        *(u32x4*)(pb + i) = w;
    }
}
DI void phase_attn(const Params& p, ldsp lds, int wvi) {
    unsigned char* ws = opq(p.ws);
    const int tid = otid(wvi), wid = tid >> 6, lane = tid & 63, fr = lane & 15, fq = lane >> 4, gi = wid >> 1, qh = wid & 1;
    LAS bf16_t* sK = (LAS bf16_t*)lds; LAS bf16_t* sVT = (LAS bf16_t*)(lds + 36864); LAS bf16_t* sP = (LAS bf16_t*)(lds + 36864 + 33792 + wid * 8448);
    const bf16_t* Q = (const bf16_t*)(ws + OFF_BQ); const bf16_t* Kg = (const bf16_t*)(ws + OFF_BK); const bf16_t* Vg = (const bf16_t*)(ws + OFF_BV);
    bf16_t* AO = (bf16_t*)(ws + OFF_AO);
    for (int un = blockIdx.x; un < 1024; un += gridDim.x) {
        const int g = un & 3, nb = (un >> 2) & 31, b = un >> 7;
        const int hq = g * 4 + gi;
        const float slope = exp2f(-0.5f * (float)(hq + 1)), sink = p.in[13][hq];
        const bf16_t* qbase = Q + ((size_t)b * SEQ + nb * 128 + 64 * qh + fr) * 1024 + hq * 64 + 8 * fq;
        bf16x8 nq0 = *(const bf16x8*)qbase, nq1 = *(const bf16x8*)(qbase + 32);
        lds_barrier();
#pragma unroll
        for (int ps = 0; ps < 4; ++ps) {
            const int idx = tid + ps * 512, kj = idx >> 3, c8 = idx & 7;
            const int tk = (nb - 1) * 128 + kj;
            u32x4 kv = {0u, 0u, 0u, 0u}, vv = {0u, 0u, 0u, 0u};
            if (tk >= 0) { const size_t off = ((size_t)b * SEQ + tk) * 256 + g * 64 + 8 * c8; kv = *(const u32x4*)(Kg + off); vv = *(const u32x4*)(Vg + off); }
            *(LAS u32x4*)(sK + kj * 72 + 8 * c8) = kv;
            const unsigned vw[4] = {vv.x, vv.y, vv.z, vv.w};
#pragma unroll
            for (int e = 0; e < 4; ++e) { sVT[(8 * c8 + 2 * e) * 264 + kj] = (bf16_t)(vw[e] & 0xffffu); sVT[(8 * c8 + 2 * e + 1) * 264 + kj] = (bf16_t)(vw[e] >> 16); }
        }
        lds_barrier();
        for (int mt = 0; mt < 4; ++mt) {
            const int q0 = 64 * qh + 16 * mt;
            const bf16x8 qf0 = nq0, qf1 = nq1;
            if (mt < 3) { nq0 = *(const bf16x8*)(qbase + (size_t)(mt + 1) * 16 * 1024); nq1 = *(const bf16x8*)(qbase + (size_t)(mt + 1) * 16 * 1024 + 32); }
            const int nt0 = 4 * qh + mt;
            f32x4 sc[9];
#pragma unroll
            for (int i = 0; i < 9; ++i) { const int nt = nt0 + i;
                f32x4 a = {0.f, 0.f, 0.f, 0.f};
                const bf16x8 k0 = *(const LAS bf16x8*)(sK + (16 * nt + fr) * 72 + 8 * fq), k1 = *(const LAS bf16x8*)(sK + (16 * nt + fr) * 72 + 32 + 8 * fq);
                a = MFMA16(k0, qf0, a); a = MFMA16(k1, qf1, a); sc[i] = a;
            }
            const int qi = q0 + fr;
            float mx = -1e30f;
#pragma unroll
            for (int i = 0; i < 9; ++i) {
#pragma unroll
                for (int j = 0; j < 4; ++j) {
                    const int kj = 16 * (nt0 + i) + 4 * fq + j, dist = qi + 128 - kj;
                    const bool valid = dist >= 0 && dist < 128 && (nb > 0 || kj >= 128);
                    const float lg = valid ? sc[i][j] * 0.125f - slope * (float)dist : -1e30f;
                    sc[i][j] = lg; mx = fmaxf(mx, lg);
                }
            }
            mx = fmaxf(mx, __shfl_xor(mx, 16)); mx = fmaxf(mx, __shfl_xor(mx, 32)); mx = fmaxf(mx, sink);
            float sm = 0.f;
#pragma unroll
            for (int i = 0; i < 9; ++i)
#pragma unroll
                for (int j = 0; j < 4; ++j) { const float e = sc[i][j] > -1e29f ? __expf(sc[i][j] - mx) : 0.f; sc[i][j] = e; sm += e; }
            sm += __shfl_xor(sm, 16); sm += __shfl_xor(sm, 32);
            sm = 1.0f / (sm + __expf(sink - mx));
#pragma unroll
            for (int i = 0; i < 9; ++i) { u32x2 w; w.x = pack2(sc[i][0] * sm, sc[i][1] * sm); w.y = pack2(sc[i][2] * sm, sc[i][3] * sm); *(LAS u32x2*)(sP + fr * 264 + 16 * (nt0 + i) + 4 * fq) = w; }
            { const int xt = (nt0 & 1) ? nt0 - 1 : nt0 + 9;
              *(LAS u32x2*)(sP + fr * 264 + 16 * xt + 4 * fq) = (u32x2){0u, 0u}; }
            asm volatile("s_waitcnt lgkmcnt(0)" ::: "memory");
            f32x4 oa[4] = {{0.f, 0.f, 0.f, 0.f}, {0.f, 0.f, 0.f, 0.f}, {0.f, 0.f, 0.f, 0.f}, {0.f, 0.f, 0.f, 0.f}};
#pragma unroll
            for (int ksi = 0; ksi < 5; ++ksi) { const int ks = (nt0 >> 1) + ksi;
                const bf16x8 pf = *(const LAS bf16x8*)(sP + fr * 264 + 32 * ks + 8 * fq);
#pragma unroll
                for (int nd = 0; nd < 4; ++nd) { const bf16x8 vf = *(const LAS bf16x8*)(sVT + (16 * nd + fr) * 264 + 32 * ks + 8 * fq); oa[nd] = MFMA16(pf, vf, oa[nd]); }
            }
            asm volatile("s_waitcnt lgkmcnt(0)" ::: "memory");
            bf16_t* op = AO + ((size_t)b * SEQ + nb * 128 + q0 + 4 * fq) * 1024 + hq * 64 + fr;
#pragma unroll
            for (int nd = 0; nd < 4; ++nd)
#pragma unroll
                for (int j = 0; j < 4; ++j) op[(size_t)j * 1024 + 16 * nd] = f2bf(oa[nd][j]);
        }
    }
}

DI void phase_final(const Params& p, const float* ss, int wvi) {
    const int tid0 = otid(wvi); const int lane = tid0 & 63, wid = tid0 >> 6;
    const float* nw = p.in[5]; float* h = p.out;
    f32x4 wv[4];
#pragma unroll
    for (int i = 0; i < 4; ++i) wv[i] = *(const f32x4*)(nw + i * 256 + lane * 4);
    const int rstep = gridDim.x * 8;
    f32x4 nv[4]; float nss;
    { const int r0 = blockIdx.x * 8 + wid; nss = ss[r0];
#pragma unroll
      for (int i = 0; i < 4; ++i) nv[i] = *(const f32x4*)(h + (size_t)r0 * 1024 + i * 256 + lane * 4); }
    for (int row = blockIdx.x * 8 + wid; row < MTOK; row += rstep) {
        f32x4 v[4]; const float css = nss;
#pragma unroll
        for (int i = 0; i < 4; ++i) v[i] = nv[i];
        if (row + rstep < MTOK) { nss = ss[row + rstep];
#pragma unroll
            for (int i = 0; i < 4; ++i) nv[i] = *(const f32x4*)(h + (size_t)(row + rstep) * 1024 + i * 256 + lane * 4); }
        const float rs = rsqrtf(css * (1.0f / 1024.0f) + 1e-6f);
#pragma unroll
        for (int i = 0; i < 4; ++i) *(f32x4*)(h + (size_t)row * 1024 + i * 256 + lane * 4) = v[i] * rs * wv[i];
    }
}

__global__ void __launch_bounds__(512, 2) hybrid_fwd(Params p) {
    extern __shared__ __attribute__((aligned(16))) unsigned char shm[];
    ldsp lds = (ldsp)shm;
    cg::grid_group grid = cg::this_grid();
    const int wvi = __builtin_amdgcn_readfirstlane((int)(threadIdx.x >> 6));
    volatile LAS unsigned* st = (volatile LAS unsigned*)(lds + LDS_ST_OFF);
    if (threadIdx.x == 0) { st[0] = 0u; st[1] = 0u; }
    __syncthreads();
    const XcdBarrier xb = xcd_barrier_post((unsigned*)(p.ws + OFF_BAR), st);
    phase_setup(p, lds, wvi);
    grid.sync();
#pragma nounroll
    for (int layer = 0; layer < 2; ++layer) {
        unsigned char* ws = opq(p.ws);
        float* ssA = (float*)(ws + OFF_SSA); float* ssB = (float*)(ws + OFF_SSB);
        float* s0 = layer ? ssB : ssA; float* s1 = layer ? ssA : ssB;
        if (layer) zero_ss(s1, wvi);
        if (layer == 0) {
            phase_ba(p, s0, wvi);
            { EpiProjA E; E.X = (bf16_t*)(ws + OFF_XQ); E.ba = (float*)(ws + OFF_BA); E.ss = s0;
              run_gemm(lds, wvi, (const bf16_t*)(ws + OFF_HB), (const bf16_t*)(ws + OFF_WA_IN), MTOK, 4096, 1024, E); }
            xcd_barrier(xb);
            phase_prep(p, lds, wvi);
            xcd_barrier(xb);
            phase_scan(p, lds, wvi);
            xcd_barrier(xb);
            phase_gate(p, wvi);
            xcd_barrier(xb);
        } else {
            { EpiProjB E; E.Q = (bf16_t*)(ws + OFF_BQ); E.K = (bf16_t*)(ws + OFF_BK); E.V = (bf16_t*)(ws + OFF_BV); E.ss = s0;
              run_gemm(lds, wvi, (const bf16_t*)(ws + OFF_HB2), (const bf16_t*)(ws + OFF_WB_IN), MTOK, 1536, 1024, E); }
            xcd_barrier(xb);
            phase_attn(p, lds, wvi);
            xcd_barrier(xb);
        }
        { EpiResidual E; E.hsrc = layer ? p.out : p.in[0]; E.hdst = p.out; E.hb = (bf16_t*)(ws + OFF_HB); E.ssout = s1; E.rowbase = 0;
          run_gemm(lds, wvi, (const bf16_t*)(ws + (layer ? OFF_AO : OFF_XQ)), (const bf16_t*)(ws + (layer ? OFF_WB_OUT : OFF_WA_OUT)), MTOK, 1024, 1024, E); }
        xcd_barrier(xb);
        const bf16_t* wup = (const bf16_t*)(ws + (layer ? OFF_WUP1 : OFF_WUP0)); const bf16_t* wdn = (const bf16_t*)(ws + (layer ? OFF_WDN1 : OFF_WDN0));
        phase_convert_p(p, layer, wvi);
        zero_ss(s0, wvi);
        { EpiUpAct E; E.ACT = (bf16_t*)(ws + OFF_ACT); E.ss = s1; E.cw = p.in[16] + (size_t)layer * 3 * NUP; E.RAW = (float*)(ws + OFF_RAW);
          run_gemm_amap(lds, wvi, (const bf16_t*)(ws + OFF_HB), wup, 128, NUP, 1024, E); }
        xcd_barrier(xb);
        zero_ss(s1, wvi);
        { pg8::StaticOrder S; S.init(MTOK, 1024, (int)gridDim.x, (int)blockIdx.x); pg8::Unit uu;
          for (int i = 0; S.next(i, uu); ++i) ffn_fixup_panel(p, layer, uu.pm, s1, wvi);
          asm volatile("s_waitcnt vmcnt(0)" ::: "memory"); __syncthreads(); }
        { EpiResidual E; E.hsrc = p.out; E.hdst = p.out; E.hb = (bf16_t*)(ws + OFF_HB); E.ssout = s0; E.rowbase = 0;
          run_gemm(lds, wvi, (const bf16_t*)(ws + OFF_ACT), wdn, MTOK, 1024, DFF, E); }
        xcd_barrier(xb);
        { EpiPlain E; E.O = (bf16_t*)(ws + OFF_PP);
          run_gemm(lds, wvi, (const bf16_t*)(ws + OFF_PB), (const bf16_t*)(ws + (layer ? OFF_WP1 : OFF_WP0)), MTOK, 1024, 256, E); }
        { EpiPle E; E.h = p.out; E.hb = (bf16_t*)(ws + OFF_HB2); E.pp = (const bf16_t*)(ws + OFF_PP); E.ssin = s0; E.ssout = s1;
          run_gemm(lds, wvi, (const bf16_t*)(ws + OFF_HB), (const bf16_t*)(ws + (layer ? OFF_WG1 : OFF_WG0)), MTOK, 1024, 1024, E); }
        xcd_barrier(xb);
    }
    phase_final(p, (const float*)(opq(p.ws) + OFF_SSA), wvi);
}

extern "C" void kernel_launch(void* const* d_in, const int* in_sizes, int n_in, void* d_out, int out_size, void* d_ws, size_t ws_size, hipStream_t stream) {
    static int grid_blocks = 0;
    if (grid_blocks == 0) {
        if (n_in != 20 || out_size != MTOK * DM || ws_size < WS_NEED) { fprintf(stderr, "kernel_launch: unexpected shapes (n_in %d, out %d, ws %zu, need %zu)\n", n_in, out_size, ws_size, (size_t)WS_NEED); grid_blocks = -1; return; }
        int dev = 0, cus = 0, per_cu = 0;
        (void)hipGetDevice(&dev);
        (void)hipDeviceGetAttribute(&cus, hipDeviceAttributeMultiprocessorCount, dev);
        if (hipFuncSetAttribute((const void*)hybrid_fwd, hipFuncAttributeMaxDynamicSharedMemorySize, LDS_BYTES) != hipSuccess) { fprintf(stderr, "kernel_launch: hipFuncSetAttribute failed\n"); grid_blocks = -1; return; }
        if (hipOccupancyMaxActiveBlocksPerMultiprocessor(&per_cu, (const void*)hybrid_fwd, 512, LDS_BYTES) != hipSuccess || per_cu < 1) { fprintf(stderr, "kernel_launch: occupancy query failed (%d)\n", per_cu); (void)hipGetLastError(); per_cu = 1; }
        if (per_cu > 1) per_cu = 1;
        grid_blocks = cus * per_cu;
    }
    if (grid_blocks < 0) return;
    Params p{};
    for (int i = 0; i < 20; ++i) p.in[i] = (const float*)d_in[i];
    p.out = (float*)d_out; p.ws = (unsigned char*)d_ws;
    if (hipMemsetAsync((char*)d_ws + OFF_BAR, 0, XCD_BAR_WORDS * sizeof(unsigned), stream) != hipSuccess) { fprintf(stderr, "kernel_launch: memset failed\n"); return; }
    void* args[] = {&p};
    hipError_t e = hipLaunchCooperativeKernel((const void*)hybrid_fwd, dim3(grid_blocks), dim3(512), args, LDS_BYTES, stream);
    if (e != hipSuccess) fprintf(stderr, "cooperative launch failed: %s (grid %d)\n", hipGetErrorString(e), grid_blocks);
}
```
